# Optimizing an MI355X kernel written in HIP

```python
import math
import jax, jax.numpy as jnp
from jax import lax
import numpy as np

D_MODEL = 1024
BATCH = 4
SEQ = 4096
DEPTH = 1

N_MOD = 6
GLA_HEADS = 4
GLA_DK = D_MODEL // 2
GLA_DV = D_MODEL
GLA_HEAD_K = GLA_DK // GLA_HEADS
GLA_HEAD_V = GLA_DV // GLA_HEADS
GLA_LOWRANK = 16
GLA_TAU = 16.0
GLA_CHUNK = 64
DIL_PATTERNS = ((128, 1), (512, 4), (2048, 16))
DIL_GROUPS = len(DIL_PATTERNS)
DIL_HEADS_PER_GROUP = 8
DIL_HEAD_DIM = 64
DIL_HEADS = DIL_GROUPS * DIL_HEADS_PER_GROUP
DIL_WIDTH = DIL_HEADS * DIL_HEAD_DIM
DIL_OUT = DIL_HEADS_PER_GROUP * DIL_HEAD_DIM
DIL_BLOCK = 128
REL_BUCKETS = 32
REL_MAX_DIST = 2048
IN_SPLITS = (GLA_DK, GLA_DK, GLA_DV, GLA_DV, GLA_LOWRANK, DIL_WIDTH, DIL_WIDTH, DIL_WIDTH, D_MODEL, D_MODEL)
IN_COLS = sum(IN_SPLITS)
MOE_GROUPS = 4
MOE_EXPERTS = 8
MOE_TOPK = 2
MOE_FF = D_MODEL // 2
LN_EPS = 1e-5

kernel_name = "hybrid_gla_dilated_attn_hmoe_deepnorm"


def layer_norm(x, g, b):
    xf = x.astype(jnp.float32)
    mu = jnp.mean(xf, -1, keepdims=True)
    var = jnp.mean(jnp.square(xf - mu), -1, keepdims=True)
    return ((xf - mu) * lax.rsqrt(var + LN_EPS) * g + b).astype(x.dtype)


def t5_bucket(dist):
    exact = REL_BUCKETS // 2
    d = jnp.maximum(dist, 1).astype(jnp.float32)
    large = exact + (jnp.log(d / exact) / math.log(REL_MAX_DIST / exact) * (REL_BUCKETS - exact)).astype(jnp.int32)
    large = jnp.minimum(large, REL_BUCKETS - 1)
    return jnp.where(dist < exact, dist, large)


def gla(q, k, v, r, lr, w_gate, b_gate, norm_g):
    B, S, _ = q.shape
    n = S // GLA_CHUNK
    log_a = jax.nn.log_sigmoid((lr @ w_gate + b_gate).astype(jnp.float32)) / GLA_TAU

    def chunks(t, hd):
        return t.reshape(B, n, GLA_CHUNK, GLA_HEADS, hd).transpose(1, 0, 3, 2, 4)

    qc = chunks(q * GLA_HEAD_K ** -0.5, GLA_HEAD_K)
    kc = chunks(k, GLA_HEAD_K)
    vc = chunks(v, GLA_HEAD_V)
    gc = chunks(log_a, GLA_HEAD_K)
    causal = jnp.tril(jnp.ones((GLA_CHUNK, GLA_CHUNK), bool))

    def step(state, inp):
        qi, ki, vi, gi = inp
        b = jnp.cumsum(gi, axis=-2)
        o_inter = jnp.einsum('bhck,bhkv->bhcv', qi * jnp.exp(b), state)
        diff = jnp.where(causal[:, :, None], b[:, :, :, None, :] - b[:, :, None, :, :], -jnp.inf)
        att = jnp.einsum('bhtk,bhtsk,bhsk->bhts', qi, jnp.exp(diff), ki)
        o_intra = jnp.einsum('bhts,bhsv->bhtv', att, vi)
        b_last = b[:, :, -1:, :]
        state = state * jnp.exp(b_last)[:, :, 0, :, None] + jnp.einsum('bhsk,bhsv->bhkv', ki * jnp.exp(b_last - b), vi)
        return state, o_inter + o_intra

    state0 = jnp.zeros((B, GLA_HEADS, GLA_HEAD_K, GLA_HEAD_V), jnp.float32)
    _, o = lax.scan(step, state0, (qc, kc, vc, gc))
    o = o.transpose(1, 0, 3, 2, 4).reshape(B, S, GLA_HEADS, GLA_HEAD_V)
    o = o * lax.rsqrt(jnp.mean(o * o, -1, keepdims=True) + LN_EPS) * norm_g.reshape(GLA_HEADS, GLA_HEAD_V)
    o = o * jax.nn.silu(r.astype(jnp.float32)).reshape(B, S, GLA_HEADS, GLA_HEAD_V)
    return o.reshape(B, S, GLA_DV).astype(q.dtype)


def dilated_group(q, k, v, bias_table, window, dilation):
    B, S, H, Dh = q.shape
    L = S // dilation
    nb = -(-L // DIL_BLOCK)
    Lp = nb * DIL_BLOCK

    def to_blocks(t):
        t = t.reshape(B, L, dilation, H, Dh).transpose(0, 2, 3, 1, 4)
        t = jnp.pad(t, ((0, 0), (0, 0), (0, 0), (0, Lp - L), (0, 0)))
        return t.reshape(B, dilation, H, nb, DIL_BLOCK, Dh)

    def with_prev(t):
        prev = jnp.pad(t, ((0, 0), (0, 0), (0, 0), (1, 0), (0, 0), (0, 0)))[:, :, :, :-1]
        return jnp.concatenate([prev, t], axis=-2)

    qb = to_blocks(q)
    kk = with_prev(to_blocks(k))
    vv = with_prev(to_blocks(v))
    s = jnp.einsum('brhnqe,brhnke->brhnqk', qb, kk).astype(jnp.float32) * Dh ** -0.5
    qi = jnp.arange(DIL_BLOCK)[:, None]
    kj = jnp.arange(2 * DIL_BLOCK)[None, :]
    m = qi + DIL_BLOCK - kj
    n_steps = window // dilation
    band = (m >= 0) & (m <= n_steps)
    key_pos = jnp.arange(nb)[:, None, None] * DIL_BLOCK - DIL_BLOCK + kj[None]
    valid = band[None] & (key_pos >= 0)
    bucket = t5_bucket(jnp.clip(m, 0, n_steps) * dilation)
    bias = jnp.transpose(bias_table[bucket], (2, 0, 1)).astype(jnp.float32)
    s = jnp.where(valid, s + bias[:, None], -jnp.inf)
    mx = jnp.max(s, axis=-1, keepdims=True)
    p = jnp.exp(s - mx)
    den = jnp.sum(p, axis=-1, keepdims=True)
    o = jnp.einsum('brhnqk,brhnke->brhnqe', p / den, vv)
    lse = (mx + jnp.log(den))[..., 0]
    o = o.reshape(B, dilation, H, Lp, Dh)[:, :, :, :L].transpose(0, 3, 1, 2, 4).reshape(B, S, H, Dh)
    lse = lse.reshape(B, dilation, H, Lp)[..., :L].transpose(0, 3, 1, 2).reshape(B, S, H)
    return o, lse


def dilated_attention(q, k, v, rel_bias):
    B, S = q.shape[:2]
    outs, lses = [], []
    for g, (window, dilation) in enumerate(DIL_PATTERNS):
        table = rel_bias[:, g * DIL_HEADS_PER_GROUP:(g + 1) * DIL_HEADS_PER_GROUP]
        o, lse = dilated_group(q[:, :, g], k[:, :, g], v[:, :, g], table, window, dilation)
        outs.append(o)
        lses.append(lse)
    wts = jax.nn.softmax(jnp.stack(lses), axis=0)
    out = jnp.einsum('gbsh,gbshe->bshe', wts, jnp.stack(outs))
    return out.reshape(B, S, DIL_OUT).astype(q.dtype)


def mixer_sublayer(u, w_in, w_gla_gate, b_gla_gate, gla_norm, w_proj_gla, w_proj_attn, w_out, rel_bias):
    B, S, _ = u.shape
    z = u @ w_in
    cuts = np.cumsum(IN_SPLITS)[:-1].tolist()
    qa, ka, va, ra, lra, qd, kd, vd, ga, gd = jnp.split(z, cuts, axis=-1)
    y_gla = gla(qa, ka, va, ra, lra, w_gla_gate, b_gla_gate, gla_norm)
    hs = (B, S, DIL_GROUPS, DIL_HEADS_PER_GROUP, DIL_HEAD_DIM)
    y_att = dilated_attention(qd.reshape(hs), kd.reshape(hs), vd.reshape(hs), rel_bias)
    merged = jax.nn.sigmoid(ga) * (y_gla @ w_proj_gla) + jax.nn.sigmoid(gd) * (y_att @ w_proj_attn)
    return merged @ w_out


def hier_moe(u, w_rg, b_rg, w_re, b_re, w_gate, w_up, w_down):
    B, S, D = u.shape
    xf = u.reshape(-1, D)
    N = xf.shape[0]
    g_logits = (xf @ w_rg + b_rg).astype(jnp.float32)
    g_prob = jax.nn.softmax(g_logits, -1)
    g_val, g_idx = lax.top_k(g_prob, 1)
    e_logits = (xf @ w_re + b_re).astype(jnp.float32).reshape(N, MOE_GROUPS, MOE_EXPERTS)
    e_in = jnp.take_along_axis(e_logits, g_idx[:, :, None], axis=1)[:, 0]
    top_v, top_i = lax.top_k(e_in, MOE_TOPK)
    top_w = jax.nn.softmax(top_v, -1)
    e_w = jnp.sum(jax.nn.one_hot(top_i, MOE_EXPERTS, dtype=jnp.float32) * top_w[..., None], axis=1)
    combine = jax.nn.one_hot(g_idx[:, 0], MOE_GROUPS, dtype=jnp.float32)[:, :, None] * (g_val * e_w)[:, None, :]
    out = jnp.zeros((N, D), jnp.float32)
    for g in range(MOE_GROUPS):
        h = jax.nn.silu(jnp.einsum('nd,edf->nef', xf, w_gate[g])) * jnp.einsum('nd,edf->nef', xf, w_up[g])
        out = out + jnp.einsum('nef,ne,efd->nd', h, combine[:, g], w_down[g])
    return out.reshape(B, S, D).astype(u.dtype)


def setup_inputs(seed: int = 0) -> dict:
    key = jax.random.key(seed)
    ks = jax.random.split(key, 24)
    beta = (8.0 * DEPTH) ** -0.25
    f32 = jnp.float32

    def nrm(k, shape, scale):
        return jax.random.normal(k, shape, f32) * scale

    starts = np.concatenate([[0], np.cumsum(IN_SPLITS)])
    col_scale = np.ones(IN_COLS, np.float32)
    col_scale[starts[2]:starts[3]] = beta
    col_scale[starts[7]:starts[8]] = beta
    Ld = DEPTH
    return {
        "x": nrm(ks[0], (BATCH, SEQ, D_MODEL), 1.0),
        "c": nrm(ks[1], (BATCH, D_MODEL), 1.0),
        "rel_bias": nrm(ks[2], (REL_BUCKETS, DIL_HEADS), 0.1),
        "w_ada": nrm(ks[3], (Ld, D_MODEL, N_MOD * D_MODEL), D_MODEL ** -0.5),
        "b_ada": nrm(ks[4], (Ld, N_MOD * D_MODEL), 0.02),
        "w_in": nrm(ks[5], (Ld, D_MODEL, IN_COLS), D_MODEL ** -0.5) * jnp.asarray(col_scale),
        "w_gla_gate": nrm(ks[6], (Ld, GLA_LOWRANK, GLA_DK), GLA_LOWRANK ** -0.5),
        "b_gla_gate": nrm(ks[7], (Ld, GLA_DK), 0.1),
        "gla_norm": 1.0 + nrm(ks[8], (Ld, GLA_DV), 0.02),
        "w_proj_gla": nrm(ks[9], (Ld, GLA_DV, D_MODEL), GLA_DV ** -0.5 * beta),
        "w_proj_attn": nrm(ks[10], (Ld, DIL_OUT, D_MODEL), DIL_OUT ** -0.5 * beta),
        "w_out": nrm(ks[11], (Ld, D_MODEL, D_MODEL), D_MODEL ** -0.5 * beta),
        "ln1_g": 1.0 + nrm(ks[12], (Ld, D_MODEL), 0.02),
        "ln1_b": nrm(ks[13], (Ld, D_MODEL), 0.02),
        "w_router_group": nrm(ks[14], (Ld, D_MODEL, MOE_GROUPS), D_MODEL ** -0.5),
        "b_router_group": nrm(ks[15], (Ld, MOE_GROUPS), 0.01),
        "w_router_expert": nrm(ks[16], (Ld, D_MODEL, MOE_GROUPS * MOE_EXPERTS), D_MODEL ** -0.5),
        "b_router_expert": nrm(ks[17], (Ld, MOE_GROUPS * MOE_EXPERTS), 0.01),
        "w_exp_gate": nrm(ks[18], (Ld, MOE_GROUPS, MOE_EXPERTS, D_MODEL, MOE_FF), D_MODEL ** -0.5),
        "w_exp_up": nrm(ks[19], (Ld, MOE_GROUPS, MOE_EXPERTS, D_MODEL, MOE_FF), D_MODEL ** -0.5 * beta),
        "w_exp_down": nrm(ks[20], (Ld, MOE_GROUPS, MOE_EXPERTS, MOE_FF, D_MODEL), MOE_FF ** -0.5 * beta),
        "ln2_g": 1.0 + nrm(ks[21], (Ld, D_MODEL), 0.02),
        "ln2_b": nrm(ks[22], (Ld, D_MODEL), 0.02),
    }


def reference(x, c, rel_bias, w_ada, b_ada, w_in, w_gla_gate, b_gla_gate, gla_norm, w_proj_gla, w_proj_attn,
              w_out, ln1_g, ln1_b, w_router_group, b_router_group, w_router_expert, b_router_expert,
              w_exp_gate, w_exp_up, w_exp_down, ln2_g, ln2_b):
    alpha = (2.0 * DEPTH) ** 0.25
    for l in range(DEPTH):
        mods = jax.nn.silu(c) @ w_ada[l] + b_ada[l]
        sh1, sc1, g1, sh2, sc2, g2 = [m[:, None, :] for m in jnp.split(mods, N_MOD, axis=-1)]
        u = x * (1.0 + sc1) + sh1
        y = mixer_sublayer(u, w_in[l], w_gla_gate[l], b_gla_gate[l], gla_norm[l], w_proj_gla[l],
                           w_proj_attn[l], w_out[l], rel_bias)
        x = layer_norm(alpha * x + g1 * y, ln1_g[l], ln1_b[l])
        u = x * (1.0 + sc2) + sh2
        y = hier_moe(u, w_router_group[l], b_router_group[l], w_router_expert[l], b_router_expert[l],
                     w_exp_gate[l], w_exp_up[l], w_exp_down[l])
        x = layer_norm(alpha * x + g2 * y, ln2_g[l], ln2_b[l])
    return x
```

```cpp
#include <hip/hip_runtime.h>
#include <cstdio>
#include <cstdint>

#ifndef MK_MULTI
#define MK_MULTI 0
#endif
#ifndef DBG_NPH
#define DBG_NPH 13
#endif
#ifndef DBG_GLA_DIFF
#define DBG_GLA_DIFF 0
#define DBG_SEQ {0, 1, 2, 3, 4, 15}
#define DBG_SRC WS_DS
#endif
#ifndef NAIVE_GEMM
#define NAIVE_GEMM 0
#endif
#ifndef NAIVE_ATTN
#define NAIVE_ATTN 0
#endif
#ifndef NAIVE_GLA
#define NAIVE_GLA 0
#endif

#define GAS __attribute__((address_space(1)))
#define LAS __attribute__((address_space(3)))
typedef unsigned short bf16;
typedef short bf16x8 __attribute__((ext_vector_type(8)));
typedef short s16x4 __attribute__((ext_vector_type(4)));
typedef float f32x4 __attribute__((ext_vector_type(4)));
typedef float f32x16 __attribute__((ext_vector_type(16)));
typedef unsigned u32x4 __attribute__((ext_vector_type(4)));
typedef unsigned u32x2 __attribute__((ext_vector_type(2)));

constexpr int NB = 4, SEQ = 4096, NTOK = NB * SEQ, D = 1024;
constexpr int NWAVES = 8, NTHR = 512;
constexpr int INCOLS = 9744, INPAD = 9984;
constexpr float LN_EPS = 1e-5f;
constexpr float ALPHA = 1.189207115002721f;
constexpr int C_QA = 0, C_KA = 512, C_VA = 1024, C_RA = 2048, C_QD = 3072, C_KD = 4608, C_VD = 6144, C_GA = 7680, C_GD = 8704, C_LR = 9728;

constexpr size_t MiB = 1u << 20;
constexpr size_t WS_CTL = 0, CTL_ZERO_BYTES = 256 * 1024;
constexpr size_t WS_MODS = 1 * MiB;
constexpr size_t WS_BTAB = WS_MODS + 128 * 1024;
constexpr size_t WS_WIN = 2 * MiB;
constexpr size_t WS_WPG = 22 * MiB, WS_WPA = 24 * MiB, WS_WOUT = 25 * MiB;
constexpr size_t WS_LR = 27 * MiB;
constexpr size_t WS_LSE = 28 * MiB;
constexpr size_t WS_DECAY = 318 * MiB;
constexpr size_t WS_QA = 30 * MiB, WS_KA = 46 * MiB, WS_VA = 62 * MiB, WS_RA = 94 * MiB;
constexpr size_t WS_QD = 126 * MiB, WS_KD = 174 * MiB, WS_VD = 222 * MiB;
constexpr size_t WS_U = 270 * MiB;
constexpr size_t WS_YGLA = 270 * MiB, WS_YATT = 302 * MiB;
constexpr size_t WS_DS = 174 * MiB;
constexpr size_t WS_MERGED = 30 * MiB;
constexpr size_t WS_T = 222 * MiB;
constexpr size_t WS_TT = 238 * MiB;
constexpr size_t WS_WGU = 126 * MiB;
constexpr size_t WS_WDN = 190 * MiB;
constexpr size_t WS_U2 = 62 * MiB;
constexpr size_t WS_LST = 94 * MiB;
constexpr size_t WS_LSTW = 96 * MiB;
constexpr size_t WS_H = 222 * MiB;
constexpr size_t WS_Y = 262 * MiB;
constexpr size_t WS_END = 326 * MiB;

constexpr int CW_CNT = 64;
constexpr int CW_BAR = 1024;

constexpr int LDS_BYTES = 163840;
constexpr int LDSCTL_OFF = 157696;
constexpr int LDS_TS = LDSCTL_OFF + 64;

#define LDS_WAIT() asm volatile("s_waitcnt lgkmcnt(0)" ::: "memory")
#define VM_WAIT() asm volatile("s_waitcnt vmcnt(0)" ::: "memory")

typedef float f32x2_t __attribute__((ext_vector_type(2))); typedef __bf16 bf16x2_t __attribute__((ext_vector_type(2)));
__device__ __forceinline__ unsigned pk2(float lo, float hi) { f32x2_t v = {lo, hi}; bf16x2_t b = __builtin_convertvector(v, bf16x2_t); return __builtin_bit_cast(unsigned, b); }
__device__ __forceinline__ bf16 f2bf(float x) { return (bf16)(pk2(x, 0.f) & 0xffffu); }
__device__ __forceinline__ float bf2f(unsigned short u) { return __uint_as_float(((unsigned)u) << 16); }
__device__ __forceinline__ float bflo(unsigned w) { return __uint_as_float(w << 16); }
__device__ __forceinline__ float bfhi(unsigned w) { return __uint_as_float(w & 0xffff0000u); }
__device__ __forceinline__ float sigmoidf_(float x) { return 1.f / (1.f + __expf(-x)); }
__device__ __forceinline__ float siluf_(float x) { return x / (1.f + __expf(-x)); }
__device__ __forceinline__ float wave_sum(float v) {
#pragma unroll
    for (int o = 1; o < 64; o <<= 1) v += __shfl_xor(v, o);
    return v;
}
__device__ __forceinline__ int crow(int r, int hi) { return (r & 3) + 8 * (r >> 2) + 4 * hi; }

#define XB_TMO      128
#define XB_XCNT(j)  (256  + 64 * (j))
#define XB_XSUB(j)  (1280 + 64 * (j))
#define XB_XGEN(j)  (2304 + 64 * (j))
#define XB_TOP      3328
#define XB_TOPGEN   3392
#define XCD_BAR_WORDS 3456
#define XB_SPIN_CAP (1u << 18)
__device__ __forceinline__ unsigned xb_ld(unsigned* p)              { return __hip_atomic_load(p, __ATOMIC_RELAXED, __HIP_MEMORY_SCOPE_AGENT); }
__device__ __forceinline__ unsigned xb_add(unsigned* p, unsigned v) { return __hip_atomic_fetch_add(p, v, __ATOMIC_RELAXED, __HIP_MEMORY_SCOPE_AGENT); }
__device__ __forceinline__ unsigned xb_xcc_id() { return (unsigned)__builtin_amdgcn_s_getreg((3 << 11) | 20) & 0xFu; }
#define XB_SPIN(cond, bar) do { unsigned _sp = 0; while (cond) { __builtin_amdgcn_s_sleep(1); \
    if ((++_sp & 255u) == 0u) { if (xb_ld(&(bar)[XB_TMO])) break; if (_sp > XB_SPIN_CAP) { atomicAdd(&(bar)[XB_TMO], 1u); break; } } } } while (0)
struct XcdBarrier { unsigned* bar; unsigned x; volatile LAS unsigned* st; };
__device__ __forceinline__ XcdBarrier xcd_barrier_post(unsigned* bar, volatile LAS unsigned* st) {
    XcdBarrier b; b.bar = bar; b.x = xb_xcc_id(); b.st = st;
    if (threadIdx.x == 0) (void)xb_add(&bar[XB_XCNT(b.x)], 1u);
    return b;
}
__device__ __forceinline__ void xcd_barrier_complete(unsigned* bar, unsigned x, unsigned& nloc, unsigned& nx) {
    const unsigned G = gridDim.x * gridDim.y * gridDim.z;
    unsigned sum, cnt, mine, sp = 0u;
    for (;;) {
        sum = 0u; cnt = 0u; mine = 0u;
#pragma unroll
        for (unsigned j = 0; j < 16; ++j) { const unsigned c = xb_ld(&bar[XB_XCNT(j)]); sum += c; cnt += (c > 0u) ? 1u : 0u; mine = (j == x) ? c : mine; }
        if (sum == G) break;
        __builtin_amdgcn_s_sleep(1);
        if ((++sp & 255u) == 0u) { if (xb_ld(&bar[XB_TMO])) break; if (sp > XB_SPIN_CAP) { atomicAdd(&bar[XB_TMO], 1u); break; } }
    }
    nloc = mine > 0u ? mine : 1u; nx = cnt > 0u ? cnt : 1u;
}
__device__ __forceinline__ void xcd_barrier(const XcdBarrier& b) {
    asm volatile("s_waitcnt vmcnt(0)" ::: "memory");
    __syncthreads();
    if (threadIdx.x == 0) {
        unsigned* bar = b.bar;
        __builtin_amdgcn_s_waitcnt(0);
        unsigned nloc = b.st[0], nx = b.st[1];
        if (nloc == 0u) { xcd_barrier_complete(bar, b.x, nloc, nx); b.st[0] = nloc; b.st[1] = nx; }
        const unsigned old = xb_add(&bar[XB_XSUB(b.x)], 1u);
        const unsigned gen = old / nloc;
        if (old + 1u == (gen + 1u) * nloc) {
            __builtin_amdgcn_fence(__ATOMIC_RELEASE, "agent");
            asm volatile("s_waitcnt vmcnt(0)" ::: "memory");
            const unsigned og = xb_add(&bar[XB_TOP], 1u);
            const unsigned tg = og / nx;
            if (og + 1u == (tg + 1u) * nx) xb_add(&bar[XB_TOPGEN], 1u);
            else XB_SPIN(xb_ld(&bar[XB_TOPGEN]) == tg, bar);
            __builtin_amdgcn_fence(__ATOMIC_ACQUIRE, "agent");
            xb_add(&bar[XB_XGEN(b.x)], 1u);
            asm volatile("s_waitcnt vmcnt(0)" ::: "memory");
        } else {
            XB_SPIN(xb_ld(&bar[XB_XGEN(b.x)]) == gen, bar);
            __builtin_amdgcn_fence(__ATOMIC_ACQUIRE, "agent");
            asm volatile("s_waitcnt vmcnt(0)" ::: "memory");
        }
    }
    __syncthreads();
}

struct Args { const float* in[23]; float* out; unsigned char* ws; int ph_lo, ph_hi; };
struct Frame {
    LAS unsigned char* lds;
    int tid, lane, wave, vcu, G;
    unsigned char* ws; float* out;
};
__device__ __forceinline__ void frame_refresh(Frame& F) { int t = threadIdx.x; asm volatile("" : "+v"(t)); F.tid = t; F.lane = t & 63; }

namespace pg8 {
constexpr int BM = 256, BK = 64, HALF = 128, HTB = HALF * BK * 2, STAGE_BYTES = 8 * HTB, NXCD = 8, WGM = 8;
__host__ __device__ __forceinline__ int lds_byte(int r, int c) { const int st = (r >> 4) * 2 + (c >> 5), rr = r & 15, cc = c & 31, ob = rr * 64 + cc * 2; return st * 1024 + (ob ^ (((ob >> 9) & 1) << 5)); }
__host__ __device__ __forceinline__ void stage_rc(int b, int& R, int& C) { const int st = b / 1024, sb = b % 1024, swz = sb ^ (((sb >> 9) & 1) << 5); R = (st >> 1) * 16 + swz / 64; C = (st & 1) * 32 + (swz % 64) / 2; }
__host__ __device__ __forceinline__ int perm32(int rho) { const int n = rho >> 4, i = rho & 15; return 8 * (i >> 2) + 4 * n + (i & 3); }

struct Unit { int pm, pn, e, mt; };

struct DenseOrder {
    static constexpr bool GATHER = false;
    int nM, nN, nwg, G, c, K;
    __device__ void init(int M, int N, int K_, int G_, int c_) { nM = M / BM; nN = N / BM; nwg = nM * nN; G = G_; c = c_; K = K_; }
    __device__ __forceinline__ bool next(int i, Unit& u) const {
        const long L = (long)i * G + c; if (L >= nwg) return false;
        int wgid = (int)L; { const int q = nwg / NXCD, r = nwg % NXCD, xcd = wgid % NXCD, off = wgid / NXCD; wgid = (xcd < r ? xcd * (q + 1) : r * (q + 1) + (xcd - r) * q) + off; }
        const int nig = WGM * nN, gid = wgid / nig, fm = gid * WGM, gsz = (nM - fm) < WGM ? (nM - fm) : WGM;
        u.pm = fm + ((wgid % nig) % gsz); u.pn = (wgid % nig) / gsz; u.e = 0; u.mt = 0; return true;
    }
    __device__ __forceinline__ size_t a_base(const Unit& u) const { return (size_t)u.pm * BM * K * 2; }
    __device__ __forceinline__ unsigned a_lane(const Unit&, int r) const { return (unsigned)r * (unsigned)K * 2u; }
    __device__ __forceinline__ size_t b_off(const Unit& u) const { return (size_t)u.pn * BM * K * 2; }
};

template <class Epi, class Sched>
__device__ __forceinline__ void gemm_phase(LAS unsigned char* lds, const bf16* Aptr, const bf16* Bptr, int K, const Sched& S, const Epi& E) {
    int tid_ = threadIdx.x; asm volatile("" : "+v"(tid_));
    const int tid = tid_, wid = __builtin_amdgcn_readfirstlane(tid >> 6), lane = tid & 63, wr = wid >> 2, wc = wid & 3, fr = lane & 15, fq = lane >> 4;
    const int nt = K / BK;
    int RA[2]; unsigned CA2[2], voffB[2];
#pragma unroll
    for (int i = 0; i < 2; ++i) { int R, C; stage_rc(tid * 16 + i * 8192, R, C); const int Rb = (R & ~31) + perm32(R & 31);
        RA[i] = R; CA2[i] = (unsigned)C * 2u; voffB[i] = (unsigned)(Rb * K + C) * 2u; }
    const size_t kstep = (size_t)(BK * 2);
    const size_t hstep = (size_t)HALF * K * 2;
    const unsigned ldsw = (unsigned)wid * 1024u;
    const int aoff = lds_byte(wr * 64 + fr, fq * 8), boff = lds_byte(wc * 32 + fr, fq * 8);
    const char* Abase = (const char*)Aptr;
#define PG8_SA(b, h) (((b) * 2 + (h)) * HTB)
#define PG8_SB(b, h) ((4 + (b) * 2 + (h)) * HTB)
#define PG8_STAGE(bufoff, gbase, voff) do { _Pragma("unroll") for (int _i = 0; _i < 2; ++_i) \
        __builtin_amdgcn_global_load_lds((const unsigned*)((const char*)(gbase) + (voff)[_i]), (LAS unsigned*)(lds + (bufoff) + ldsw + _i * 8192), 16, 0, 0); } while (0)
#define PG8_LDA(dst, b, h) do { _Pragma("unroll") for (int m = 0; m < 4; ++m) _Pragma("unroll") for (int k = 0; k < 2; ++k) dst[m][k] = *(const LAS bf16x8*)(lds + PG8_SA(b, h) + aoff + m * 2048 + k * 1024); } while (0)
#define PG8_LDB(dst, b, h) do { _Pragma("unroll") for (int n = 0; n < 2; ++n) _Pragma("unroll") for (int k = 0; k < 2; ++k) dst[n][k] = *(const LAS bf16x8*)(lds + PG8_SB(b, h) + boff + n * 2048 + k * 1024); } while (0)
#define PG8_MMA(ai, bj, At, Bt) do { __builtin_amdgcn_s_setprio(1); _Pragma("unroll") for (int m = 0; m < 4; ++m) _Pragma("unroll") for (int n = 0; n < 2; ++n) _Pragma("unroll") for (int k = 0; k < 2; ++k) \
        acc[ai][bj][m][n] = __builtin_amdgcn_mfma_f32_16x16x32_bf16(Bt[n][k], At[m][k], acc[ai][bj][m][n], 0, 0, 0); __builtin_amdgcn_s_setprio(0); } while (0)
#define PG8_WAIT_V(n) asm volatile("s_waitcnt vmcnt(" #n ")" ::: "memory")
#define PG8_WAIT_L(n) asm volatile("s_waitcnt lgkmcnt(" #n ")" ::: "memory")
#define PG8_BAR __builtin_amdgcn_s_barrier()
#define PG8_SCHED __builtin_amdgcn_sched_barrier(0)
    Unit cur, nxt; int ui = 0;
    if (!S.next(0, cur)) return;
    f32x4 acc[2][2][4][2];
#pragma unroll
    for (int a = 0; a < 2; ++a)
#pragma unroll
        for (int b = 0; b < 2; ++b)
#pragma unroll
            for (int m = 0; m < 4; ++m)
#pragma unroll
                for (int n = 0; n < 2; ++n) acc[a][b][m][n] = (f32x4){0.f, 0.f, 0.f, 0.f};
    bf16x8 At[4][2], B0[2][2], B1[2][2];
    unsigned vA0[2], vA1[2], nA0[2], nA1[2];
#pragma unroll
    for (int i = 0; i < 2; ++i) { vA0[i] = S.a_lane(cur, RA[i]) + CA2[i]; vA1[i] = S.a_lane(cur, HALF + RA[i]) + CA2[i]; }
    const char* cB = (const char*)Bptr + S.b_off(cur);
    const char* cA = Abase + S.a_base(cur);
    if (Sched::GATHER) VM_WAIT();
    PG8_STAGE(PG8_SB(0, 0), cB, voffB); PG8_STAGE(PG8_SB(0, 1), cB + hstep, voffB); PG8_STAGE(PG8_SA(0, 0), cA, vA0); PG8_STAGE(PG8_SA(0, 1), cA, vA1);
    if (wr == 1) PG8_BAR;
    PG8_WAIT_V(2); PG8_BAR;
    PG8_STAGE(PG8_SB(1, 0), cB + kstep, voffB); PG8_STAGE(PG8_SA(1, 0), cA + kstep, vA0); PG8_STAGE(PG8_SB(1, 1), cB + hstep + kstep, voffB);
    PG8_WAIT_V(6); PG8_BAR;
    for (;;) {
        const bool has_next = S.next(ui + 1, nxt);
        const char* nB = cB; const char* nA = cA;
        if (has_next) {
            int t2 = tid; if (Sched::GATHER) asm volatile("" : "+v"(t2));
#pragma unroll
            for (int i = 0; i < 2; ++i) { int R, C; stage_rc(t2 * 16 + i * 8192, R, C); nA0[i] = S.a_lane(nxt, R) + (unsigned)C * 2u; nA1[i] = S.a_lane(nxt, HALF + R) + (unsigned)C * 2u; }
            nB = (const char*)Bptr + S.b_off(nxt); nA = Abase + S.a_base(nxt);
            if (Sched::GATHER) VM_WAIT();
        } else {
#pragma unroll
            for (int i = 0; i < 2; ++i) { nA0[i] = vA0[i]; nA1[i] = vA1[i]; }
        }
        for (int t = 0; t < nt; t += 2) {
            const bool last = (t == nt - 2);
            const size_t k1 = (size_t)(t + 1) * kstep;
            const size_t k2 = (size_t)(t + 2) * kstep;
            unsigned w0[2], w1[2];
#pragma unroll
            for (int i = 0; i < 2; ++i) { w0[i] = last ? nA0[i] : vA0[i]; w1[i] = last ? nA1[i] : vA1[i]; }
            const char* b2 = last ? nB : cB + (size_t)(t + 2) * kstep; const char* b3 = b2 + kstep;
            const char* a1p = cA + k1; const char* a2p = last ? nA : cA + k2; const char* a3p = a2p + kstep;
            PG8_LDB(B0, 0, 0); PG8_LDB(B1, 0, 1); PG8_SCHED; PG8_LDA(At, 0, 0); PG8_STAGE(PG8_SA(1, 1), a1p, vA1);
            PG8_WAIT_V(8); PG8_WAIT_L(0); PG8_BAR; PG8_MMA(0, 0, At, B0); PG8_MMA(0, 1, At, B1); PG8_BAR; PG8_SCHED;
            PG8_LDA(At, 0, 1); PG8_STAGE(PG8_SB(0, 0), b2, voffB); PG8_STAGE(PG8_SB(0, 1), b2 + hstep, voffB); PG8_STAGE(PG8_SA(0, 0), a2p, w0);
            PG8_WAIT_V(8); PG8_WAIT_L(0); PG8_BAR; PG8_MMA(1, 0, At, B0); PG8_MMA(1, 1, At, B1); PG8_BAR; PG8_SCHED;
            PG8_LDB(B0, 1, 0); PG8_LDB(B1, 1, 1); PG8_SCHED; PG8_LDA(At, 1, 0); PG8_STAGE(PG8_SA(0, 1), a2p, w1);
            PG8_WAIT_V(8); PG8_WAIT_L(0); PG8_BAR; PG8_MMA(0, 0, At, B0); PG8_MMA(0, 1, At, B1); PG8_BAR; PG8_SCHED;
            PG8_LDA(At, 1, 1); PG8_STAGE(PG8_SB(1, 0), b3, voffB); PG8_STAGE(PG8_SB(1, 1), b3 + hstep, voffB); PG8_STAGE(PG8_SA(1, 0), a3p, w0);
            PG8_WAIT_V(8); PG8_WAIT_L(0); PG8_BAR; PG8_MMA(1, 0, At, B0); PG8_MMA(1, 1, At, B1); PG8_BAR; PG8_SCHED;
        }
        if (wr == 0) PG8_BAR;
        E(acc, cur, wr, wc, fr, fq);
        if (!has_next) break;
#pragma unroll
        for (int a = 0; a < 2; ++a)
#pragma unroll
            for (int b = 0; b < 2; ++b)
#pragma unroll
                for (int m = 0; m < 4; ++m)
#pragma unroll
                    for (int n = 0; n < 2; ++n) acc[a][b][m][n] = (f32x4){0.f, 0.f, 0.f, 0.f};
        cur = nxt; cB = nB; cA = nA; ++ui;
#pragma unroll
        for (int i = 0; i < 2; ++i) { vA0[i] = nA0[i]; vA1[i] = nA1[i]; }
        if (wr == 1) PG8_BAR;
    }
    PG8_WAIT_V(0);
    PG8_BAR;
#undef PG8_SA
#undef PG8_SB
#undef PG8_STAGE
#undef PG8_LDA
#undef PG8_LDB
#undef PG8_MMA
#undef PG8_WAIT_V
#undef PG8_WAIT_L
#undef PG8_BAR
#undef PG8_SCHED
}

template <class Epi, class Sched>
__device__ __forceinline__ void gemm_naive(const bf16* Aptr, const bf16* Bptr, int K, const Sched& S, const Epi& E) {
    Unit u;
    for (int i = 0; S.next(i, u); ++i) {
        const char* cB = (const char*)Bptr + S.b_off(u);
        for (int ch = threadIdx.x; ch < 256 * 32; ch += NTHR) {
            const int r = ch >> 5, c = (ch & 31) * 8;
            const bf16* a = (const bf16*)((const char*)Aptr + S.a_base(u) + S.a_lane(u, r));
            float s[8];
#pragma unroll
            for (int j = 0; j < 8; ++j) s[j] = 0.f;
            for (int k = 0; k < K; k += 8) {
                const u32x4 av = *(const u32x4*)(a + k);
                float af[8] = {bflo(av.x), bfhi(av.x), bflo(av.y), bfhi(av.y), bflo(av.z), bfhi(av.z), bflo(av.w), bfhi(av.w)};
#pragma unroll
                for (int j = 0; j < 8; ++j) {
                    const u32x4 bv = *(const u32x4*)((const bf16*)cB + (size_t)(c + j) * K + k);
                    s[j] += af[0] * bflo(bv.x) + af[1] * bfhi(bv.x) + af[2] * bflo(bv.y) + af[3] * bfhi(bv.y) + af[4] * bflo(bv.z) + af[5] * bfhi(bv.z) + af[6] * bflo(bv.w) + af[7] * bfhi(bv.w);
                }
            }
            E.chunk(u, r, c, (f32x4){s[0], s[1], s[2], s[3]}, (f32x4){s[4], s[5], s[6], s[7]});
        }
    }
}

template <class F> struct EpiWrap {
    F f;
    __device__ __forceinline__ void operator()(const f32x4 (&acc)[2][2][4][2], const Unit& u, int wr, int wc, int fr, int fq) const {
#pragma unroll
        for (int ai = 0; ai < 2; ++ai)
#pragma unroll
            for (int m = 0; m < 4; ++m) {
                const int r = ai * HALF + wr * 64 + m * 16 + fr;
#pragma unroll
                for (int bj = 0; bj < 2; ++bj) f.chunk(u, r, bj * HALF + wc * 32 + 8 * fq, acc[ai][bj][m][0], acc[ai][bj][m][1]);
            }
    }
    __device__ __forceinline__ void chunk(const Unit& u, int r, int c, f32x4 v0, f32x4 v1) const { f.chunk(u, r, c, v0, v1); }
};
}
using pg8::Unit;

template <class F, class Sched>
__device__ __forceinline__ void run_gemm(Frame& Fm, const bf16* A, const bf16* Bt, int K, const Sched& S, const F& f) {
    pg8::EpiWrap<F> E{f};
#if NAIVE_GEMM
    pg8::gemm_naive(A, Bt, K, S, E);
    VM_WAIT(); __syncthreads();
#else
    pg8::gemm_phase(Fm.lds, A, Bt, K, S, E);
#endif
}

__device__ __forceinline__ u32x4 pack8(f32x4 a, f32x4 b) { u32x4 w; w.x = pk2(a[0], a[1]); w.y = pk2(a[2], a[3]); w.z = pk2(b[0], b[1]); w.w = pk2(b[2], b[3]); return w; }
__device__ __forceinline__ void unpack8(u32x4 w, f32x4& a, f32x4& b) { a = (f32x4){bflo(w.x), bfhi(w.x), bflo(w.y), bfhi(w.y)}; b = (f32x4){bflo(w.z), bfhi(w.z), bflo(w.w), bfhi(w.w)}; }

struct EpiInProj {
    unsigned char* ws; bf16* ga; bf16* gd;
    __device__ __forceinline__ void chunk(const Unit& u, int r, int c, f32x4 v0, f32x4 v1) const {
        const int row = u.pm * 256 + r, col = u.pn * 256 + c;
        bf16* dst; float sc = 1.f; int act = 0;
        if (col < C_KA)      { dst = (bf16*)(ws + WS_QA) + (size_t)row * 512 + (col - C_QA); sc = 0.08838834764831845f; }
        else if (col < C_VA) { dst = (bf16*)(ws + WS_KA) + (size_t)row * 512 + (col - C_KA); }
        else if (col < C_RA) { dst = (bf16*)(ws + WS_VA) + (size_t)row * 1024 + (col - C_VA); }
        else if (col < C_QD) { dst = (bf16*)(ws + WS_RA) + (size_t)row * 1024 + (col - C_RA); act = 1; }
        else if (col < C_KD) { dst = (bf16*)(ws + WS_QD) + (size_t)row * 1536 + (col - C_QD); sc = 0.125f; }
        else if (col < C_VD) { dst = (bf16*)(ws + WS_KD) + (size_t)row * 1536 + (col - C_KD); }
        else if (col < C_GA) { dst = (bf16*)(ws + WS_VD) + (size_t)row * 1536 + (col - C_VD); }
        else if (col < C_GD) { dst = ga + (size_t)row * 1024 + (col - C_GA); act = 2; }
        else if (col < C_LR) { dst = gd + (size_t)row * 1024 + (col - C_GD); act = 2; }
        else {
            if (col < C_LR + 16) { float* l = (float*)(ws + WS_LR) + (size_t)row * 16 + (col - C_LR); *(f32x4*)l = v0; *(f32x4*)(l + 4) = v1; }
            return;
        }
        if (act == 1) {
#pragma unroll
            for (int j = 0; j < 4; ++j) { v0[j] = siluf_(v0[j]); v1[j] = siluf_(v1[j]); }
        } else if (act == 2) {
#pragma unroll
            for (int j = 0; j < 4; ++j) { v0[j] = sigmoidf_(v0[j]); v1[j] = sigmoidf_(v1[j]); }
        } else { v0 = v0 * sc; v1 = v1 * sc; }
        *(u32x4*)dst = pack8(v0, v1);
    }
};
struct EpiProjA {
    const bf16* gd; bf16* T;
    __device__ __forceinline__ void chunk(const Unit& u, int r, int c, f32x4 v0, f32x4 v1) const {
        const size_t o = (size_t)(u.pm * 256 + r) * 1024 + u.pn * 256 + c;
        f32x4 g0, g1; unpack8(*(const u32x4*)(gd + o), g0, g1);
        *(u32x4*)(T + o) = pack8(v0 * g0, v1 * g1);
    }
};
struct EpiProjG {
    const bf16* ga; const bf16* T; bf16* merged;
    __device__ __forceinline__ void chunk(const Unit& u, int r, int c, f32x4 v0, f32x4 v1) const {
        const size_t o = (size_t)(u.pm * 256 + r) * 1024 + u.pn * 256 + c;
        f32x4 g0, g1, t0, t1; unpack8(*(const u32x4*)(ga + o), g0, g1); unpack8(*(const u32x4*)(T + o), t0, t1);
        *(u32x4*)(merged + o) = pack8(v0 * g0 + t0, v1 * g1 + t1);
    }
};
struct EpiOut {
    const float* x; const float* mods; float* t1;
    __device__ __forceinline__ void chunk(const Unit& u, int r, int c, f32x4 v0, f32x4 v1) const {
        const int row = u.pm * 256 + r, col = u.pn * 256 + c, b = row >> 12;
        const size_t o = (size_t)row * 1024 + col;
        const float* g = mods + b * 6144 + 2 * 1024 + col;
        const f32x4 x0 = *(const f32x4*)(x + o), x1 = *(const f32x4*)(x + o + 4), g0 = *(const f32x4*)g, g1v = *(const f32x4*)(g + 4);
        *(f32x4*)(t1 + o) = x0 * ALPHA + g0 * v0; *(f32x4*)(t1 + o + 4) = x1 * ALPHA + g1v * v1;
    }
};
struct EpiMoeUp {
    bf16* H;
    __device__ __forceinline__ void chunk(const Unit& u, int r, int c, f32x4 v0, f32x4 v1) const {
        const size_t row = (size_t)u.pm * 256 + r; const int f = ((u.pn * 256 + c) >> 3) * 4;
        u32x2 w; w.x = pk2(siluf_(v0[0]) * v1[0], siluf_(v0[1]) * v1[1]); w.y = pk2(siluf_(v0[2]) * v1[2], siluf_(v0[3]) * v1[3]);
        *(u32x2*)(H + row * 512 + f) = w;
    }
};
struct EpiMoeDown {
    const unsigned* cnt; const unsigned* lst; const float* lstw; bf16* Y;
    __device__ __forceinline__ void chunk(const Unit& u, int r, int c, f32x4 v0, f32x4 v1) const {
        const unsigned pos = (unsigned)(u.mt * 256 + r);
        if (pos < cnt[u.e]) {
            const unsigned ent = lst[(size_t)u.e * NTOK + pos]; const float w = lstw[(size_t)u.e * NTOK + pos];
            bf16* dst = Y + ((size_t)(ent & 1u) * NTOK + (ent >> 1)) * 1024 + u.pn * 256 + c;
            *(u32x4*)dst = pack8(v0 * w, v1 * w);
        }
    }
};
struct MoeOrder {
    static constexpr bool GATHER = true;
    const LAS int* ts; const unsigned* cnt; const unsigned* lst; int G, c, mode;
    __device__ __forceinline__ bool next(int i, Unit& u) const {
        const int L = i * G + c, ntile = ts[32]; if (L >= 4 * ntile) return false;
        const int T = L >> 2; int e = 0;
        for (int j = 1; j < 32; ++j) e += (ts[j] <= T) ? 1 : 0;
        u.pm = T; u.pn = L & 3; u.e = e; u.mt = T - ts[e]; return true;
    }
    __device__ __forceinline__ size_t a_base(const Unit& u) const { return mode == 0 ? (size_t)0 : (size_t)u.pm * 256 * 1024; }
    __device__ __forceinline__ unsigned a_lane(const Unit& u, int r) const {
        if (mode == 0) { unsigned pos = (unsigned)(u.mt * 256 + r); if (pos >= cnt[u.e]) pos = 0; return (lst[(size_t)u.e * NTOK + pos] >> 1) * 2048u; }
        return (unsigned)r * 1024u;
    }
    __device__ __forceinline__ size_t b_off(const Unit& u) const {
        return mode == 0 ? ((size_t)u.e * 1024 + (size_t)u.pn * 256) * 1024 * 2 : ((size_t)u.e * 1024 + (size_t)u.pn * 256) * 512 * 2;
    }
};

struct MapWin { __device__ __forceinline__ int operator()(int n) const { return n < 3072 ? n : (n < 3088 ? C_LR + (n - 3072) : n - 16); } };
struct MapId { __device__ __forceinline__ int operator()(int n) const { return n; } };
struct MapGate { __device__ __forceinline__ int operator()(int f) const { return (f >> 2) * 8 + (f & 3); } };
struct MapUp { __device__ __forceinline__ int operator()(int f) const { return (f >> 2) * 8 + 4 + (f & 3); } };
template <class RowMap>
__device__ __forceinline__ void transpose_item(const float* W, int K, int N, bf16* WT, LAS float* scr, int item, int lane, RowMap rm) {
    const int nblk = (N + 31) / 32, kb = item / nblk, nb = item % nblk, k0 = 64 * kb, n0 = 32 * nb;
    const int nc = n0 + (lane & 31); const bool ok = nc < N;
#pragma unroll 8
    for (int i = 0; i < 32; ++i) { const int kk = 2 * i + (lane >> 5); scr[kk * 33 + (lane & 31)] = ok ? W[(size_t)(k0 + kk) * N + nc] : 0.f; }
    LDS_WAIT(); asm volatile("" ::: "memory");
    const int c = lane & 7;
#pragma unroll
    for (int j = 0; j < 4; ++j) { const int n = (lane >> 3) + 8 * j; const LAS float* s = scr + (8 * c) * 33 + n;
        u32x4 o; o.x = pk2(s[0 * 33], s[1 * 33]); o.y = pk2(s[2 * 33], s[3 * 33]); o.z = pk2(s[4 * 33], s[5 * 33]); o.w = pk2(s[6 * 33], s[7 * 33]);
        if (n0 + n < N) *(u32x4*)(WT + (size_t)rm(n0 + n) * K + k0 + 8 * c) = o; }
    LDS_WAIT(); asm volatile("" ::: "memory");
}
__device__ __forceinline__ int t5_bucket(int dist) {
    if (dist < 16) return dist;
    int large = 16 + (int)(log((double)dist / 16.0) / log(128.0) * 16.0);
    return large < 31 ? large : 31;
}
__device__ __forceinline__ void p0_phase(Frame& F, const Args& args) {
    LAS float* scr = (LAS float*)(F.lds + F.wave * 16384);
    LAS f32x4* sc = (LAS f32x4*)(F.lds + 131072);
    const float* c = args.in[1];
    for (int k = F.tid; k < 1024; k += NTHR) sc[k] = (f32x4){siluf_(c[k]), siluf_(c[1024 + k]), siluf_(c[2048 + k]), siluf_(c[3072 + k])};
    __syncthreads();
    const int gw = F.vcu * NWAVES + F.wave, NGW = F.G * NWAVES, lane = F.lane;
    float* mods = (float*)(F.ws + WS_MODS);
#pragma unroll 1
    for (int it = gw; it < 384; it += NGW) {
        const int col = it * 16 + (lane & 15), kq = lane >> 4; const float* w = args.in[3] + col;
        float a0 = 0.f, a1 = 0.f, a2 = 0.f, a3 = 0.f;
#pragma unroll 8
        for (int k = kq; k < 1024; k += 4) { const float wv = w[(size_t)k * 6144]; const f32x4 s = sc[k]; a0 += s.x * wv; a1 += s.y * wv; a2 += s.z * wv; a3 += s.w * wv; }
        a0 += __shfl_xor(a0, 16); a0 += __shfl_xor(a0, 32); a1 += __shfl_xor(a1, 16); a1 += __shfl_xor(a1, 32);
        a2 += __shfl_xor(a2, 16); a2 += __shfl_xor(a2, 32); a3 += __shfl_xor(a3, 16); a3 += __shfl_xor(a3, 32);
        if (lane < 16) { const float bb = args.in[4][col]; mods[col] = a0 + bb; mods[6144 + col] = a1 + bb; mods[2 * 6144 + col] = a2 + bb; mods[3 * 6144 + col] = a3 + bb; }
    }
    if (gw == NGW - 1) {
        float* bt = (float*)(F.ws + WS_BTAB);
        for (int i = lane; i < 24 * 129; i += 64) { const int h = i / 129, m = i % 129, dil = (h < 8) ? 1 : (h < 16 ? 4 : 16); bt[h * 132 + m] = args.in[2][t5_bucket(m * dil) * 24 + h]; }
    }
    constexpr int I_IN = 16 * 305, I_PG = 16 * 32, I_PA = 8 * 32, I_OUT = 16 * 32, I_PAD = 240;
    constexpr int NIT = I_IN + I_PG + I_PA + I_OUT + I_PAD;
#pragma unroll 1
    for (int it = gw; it < NIT; it += NGW) {
        int r = it;
        if (r < I_IN) { transpose_item(args.in[5], 1024, INCOLS, (bf16*)(F.ws + WS_WIN), scr, r, lane, MapWin()); continue; } r -= I_IN;
        if (r < I_PG) { transpose_item(args.in[9], 1024, 1024, (bf16*)(F.ws + WS_WPG), scr, r, lane, MapId()); continue; } r -= I_PG;
        if (r < I_PA) { transpose_item(args.in[10], 512, 1024, (bf16*)(F.ws + WS_WPA), scr, r, lane, MapId()); continue; } r -= I_PA;
        if (r < I_OUT) { transpose_item(args.in[11], 1024, 1024, (bf16*)(F.ws + WS_WOUT), scr, r, lane, MapId()); continue; } r -= I_OUT;
        { u32x4* z = (u32x4*)((bf16*)(F.ws + WS_WIN) + (size_t)(INCOLS + r) * 1024); z[lane] = (u32x4){0u, 0u, 0u, 0u}; z[64 + lane] = (u32x4){0u, 0u, 0u, 0u}; }
    }
}
__device__ __forceinline__ void convert_experts(Frame& F, const Args& args) {
    LAS float* scr = (LAS float*)(F.lds + F.wave * 16384);
    const int gw = F.vcu * NWAVES + F.wave, NGW = F.G * NWAVES, lane = F.lane;
    bf16* wgu = (bf16*)(F.ws + WS_WGU); bf16* wdn = (bf16*)(F.ws + WS_WDN);
#pragma unroll 1
    for (int it = gw; it < 3 * 8192; it += NGW) {
        const int kind = it >> 13, r = it & 8191, e = r >> 8, sub = r & 255;
        if (kind == 0) transpose_item(args.in[18] + (size_t)e * 1024 * 512, 1024, 512, wgu + (size_t)e * 1024 * 1024, scr, sub, lane, MapGate());
        else if (kind == 1) transpose_item(args.in[19] + (size_t)e * 1024 * 512, 1024, 512, wgu + (size_t)e * 1024 * 1024, scr, sub, lane, MapUp());
        else transpose_item(args.in[20] + (size_t)e * 512 * 1024, 512, 1024, wdn + (size_t)e * 1024 * 512, scr, sub, lane, MapId());
    }
}
__device__ __forceinline__ void p0b_phase(Frame& F, const Args& args) {
    const int gw = F.vcu * NWAVES + F.wave, NGW = F.G * NWAVES, lane = F.lane;
    const float* mods = (const float*)(F.ws + WS_MODS); bf16* U = (bf16*)(F.ws + WS_U);
#pragma unroll 1
    for (int m = gw; m < NTOK; m += NGW) {
        const int b = m >> 12; const f32x4* xr = (const f32x4*)(args.in[0] + (size_t)m * 1024) + lane;
        const f32x4* sh = (const f32x4*)(mods + b * 6144) + lane; const f32x4* sc = (const f32x4*)(mods + b * 6144 + 1024) + lane;
        u32x2* o = (u32x2*)(U + (size_t)m * 1024) + lane;
#pragma unroll
        for (int j = 0; j < 4; ++j) { const f32x4 v = xr[64 * j] * (sc[64 * j] + 1.f) + sh[64 * j]; u32x2 w; w.x = pk2(v[0], v[1]); w.y = pk2(v[2], v[3]); o[64 * j] = w; }
    }
}

__device__ __forceinline__ s16x4 tr_read(const LAS unsigned char* p) {
    typedef short v4i16_t __attribute__((ext_vector_type(4)));
    return __builtin_bit_cast(s16x4, __builtin_amdgcn_ds_read_tr16_b64_v4i16((LAS v4i16_t*)p));
}
__device__ __forceinline__ void attn_phase(Frame& F) {
    const int tid = F.tid, lane = F.lane, wid = F.wave, half = wid >> 2, w4 = wid & 3, l31 = lane & 31, hi = lane >> 5;
    LAS unsigned char* Kl = F.lds + half * 36864;
    LAS unsigned char* Vl = F.lds + 73728 + half * 36864;
    LAS float* bl = (LAS float*)(F.lds + 147456) + half * 192;
    bf16* QD = (bf16*)(F.ws + WS_QD); const bf16* KD = (const bf16*)(F.ws + WS_KD); const bf16* VD = (const bf16*)(F.ws + WS_VD);
    float* LSE = (float*)(F.ws + WS_LSE); const float* BT = (const float*)(F.ws + WS_BTAB);
#pragma unroll 1
    for (int it = 0;; ++it) {
        const int L = it * F.G + F.vcu; if (L >= 1536) break;
        const int g = L >> 9, wq = L & 511, b = wq >> 7, w2 = wq & 127, hp = w2 >> 5, w3 = w2 & 31;
        const int dsh = 2 * g, dil = 1 << dsh, nblk = 32 >> dsh, r = w3 / nblk, nb = w3 % nblk;
        const int head = 2 * hp + half, colb = g * 512 + head * 64;
        __syncthreads();
        {
            const int t = tid & 255, ch = t & 7;
#pragma unroll
            for (int p = 0; p < 8; ++p) {
                const int row = p * 32 + (t >> 3), lidx = nb * 128 - 128 + row;
                u32x4 kv = (u32x4){0u, 0u, 0u, 0u}, vv = kv;
                if (lidx >= 0) { const size_t o = (size_t)(b * SEQ + lidx * dil + r) * 1536 + colb + ch * 8; kv = *(const u32x4*)(KD + o); vv = *(const u32x4*)(VD + o); }
                *(LAS u32x4*)(Kl + row * 144 + ch * 16) = kv; *(LAS u32x4*)(Vl + row * 144 + ch * 16) = vv;
            }
            if (t < 192) bl[t] = (t >= 32 && t <= 160) ? BT[(g * 8 + head) * 132 + t - 32] : 0.f;
        }
        const int qi = 32 * w4 + l31; const size_t qtok = (size_t)(b * SEQ + (nb * 128 + qi) * dil + r);
        bf16x8 qf[4];
#pragma unroll
        for (int kk = 0; kk < 4; ++kk) qf[kk] = *(const bf16x8*)(QD + qtok * 1536 + colb + kk * 16 + hi * 8);
        __syncthreads();
        f32x16 sa[5]; float mx = -INFINITY;
        const int mb = l31 + 128 - 4 * hi;
        const LAS float* blq = bl + (mb - 123);
        const unsigned mlim = (nb > 0) ? 128u : (unsigned)(qi < 128 ? qi : 128);
#pragma unroll
        for (int t = 0; t < 5; ++t) {
            const int kt = w4 + t; const bool act = (nb > 0) || (kt >= 4);
            f32x16 a = {0.f, 0.f, 0.f, 0.f, 0.f, 0.f, 0.f, 0.f, 0.f, 0.f, 0.f, 0.f, 0.f, 0.f, 0.f, 0.f};
            if (act) {
                const LAS unsigned char* kp = Kl + (32 * kt + l31) * 144 + hi * 16;
#pragma unroll
                for (int kk = 0; kk < 4; ++kk) { const bf16x8 kf = *(const LAS bf16x8*)(kp + kk * 32); a = __builtin_amdgcn_mfma_f32_32x32x16_bf16(kf, qf[kk], a, 0, 0, 0); }
            }
#pragma unroll
            for (int rr = 0; rr < 16; ++rr) {
                const int cc = 32 * t + (rr & 3) + 8 * (rr >> 2);
                const unsigned m = (unsigned)(mb - cc);
                float s = a[rr] + blq[155 - cc];
                s = (m <= mlim) ? s : -INFINITY;
                a[rr] = s; mx = fmaxf(mx, s);
            }
            sa[t] = a;
        }
        mx = fmaxf(mx, __shfl_xor(mx, 32));
        float sum = 0.f;
#pragma unroll
        for (int t = 0; t < 5; ++t)
#pragma unroll
            for (int rr = 0; rr < 16; ++rr) { const float p = __expf(sa[t][rr] - mx); sa[t][rr] = p; sum += p; }
        sum += __shfl_xor(sum, 32);
        f32x16 o0 = {0.f, 0.f, 0.f, 0.f, 0.f, 0.f, 0.f, 0.f, 0.f, 0.f, 0.f, 0.f, 0.f, 0.f, 0.f, 0.f}, o1 = o0;
        const int i16 = lane & 15, g2 = (lane >> 4) & 1;
        const LAS unsigned char* vbase = Vl + (4 * hi + (i16 >> 2)) * 144 + (16 * g2 + 4 * (i16 & 3)) * 2;
#pragma unroll
        for (int t = 0; t < 5; ++t) {
            const int kt = w4 + t; const bool act = (nb > 0) || (kt >= 4);
            if (act) {
#pragma unroll
                for (int s2 = 0; s2 < 2; ++s2) {
                    u32x4 pw; pw.x = pk2(sa[t][8 * s2 + 0], sa[t][8 * s2 + 1]); pw.y = pk2(sa[t][8 * s2 + 2], sa[t][8 * s2 + 3]); pw.z = pk2(sa[t][8 * s2 + 4], sa[t][8 * s2 + 5]); pw.w = pk2(sa[t][8 * s2 + 6], sa[t][8 * s2 + 7]);
                    const bf16x8 pf = __builtin_bit_cast(bf16x8, pw);
                    const LAS unsigned char* vp = vbase + (32 * kt + 16 * s2) * 144;
                    const s16x4 a0 = tr_read(vp), a1 = tr_read(vp + 8 * 144), c0 = tr_read(vp + 64), c1 = tr_read(vp + 8 * 144 + 64);
                    const bf16x8 vf0 = (bf16x8){a0[0], a0[1], a0[2], a0[3], a1[0], a1[1], a1[2], a1[3]};
                    const bf16x8 vf1 = (bf16x8){c0[0], c0[1], c0[2], c0[3], c1[0], c1[1], c1[2], c1[3]};
                    o0 = __builtin_amdgcn_mfma_f32_32x32x16_bf16(vf0, pf, o0, 0, 0, 0);
                    o1 = __builtin_amdgcn_mfma_f32_32x32x16_bf16(vf1, pf, o1, 0, 0, 0);
                }
            }
        }
        const float inv = 1.f / sum;
        bf16* orow = QD + qtok * 1536 + colb;
#pragma unroll
        for (int a4 = 0; a4 < 4; ++a4) {
            u32x2 w0, w1;
            w0.x = pk2(o0[4 * a4] * inv, o0[4 * a4 + 1] * inv); w0.y = pk2(o0[4 * a4 + 2] * inv, o0[4 * a4 + 3] * inv);
            w1.x = pk2(o1[4 * a4] * inv, o1[4 * a4 + 1] * inv); w1.y = pk2(o1[4 * a4 + 2] * inv, o1[4 * a4 + 3] * inv);
            *(u32x2*)(orow + 8 * a4 + 4 * hi) = w0; *(u32x2*)(orow + 32 + 8 * a4 + 4 * hi) = w1;
        }
        if (hi == 0) LSE[qtok * 24 + g * 8 + head] = mx + __logf(sum);
    }
    __syncthreads();
}
__device__ __forceinline__ void combine_phase(Frame& F) {
    const int gw = F.vcu * NWAVES + F.wave, NGW = F.G * NWAVES, lane = F.lane, hh = lane >> 3, ch = lane & 7;
    const bf16* OG = (const bf16*)(F.ws + WS_QD); const float* LSE = (const float*)(F.ws + WS_LSE); bf16* YA = (bf16*)(F.ws + WS_YATT);
#pragma unroll 1
    for (int m = gw; m < NTOK; m += NGW) {
        const float l0 = LSE[(size_t)m * 24 + hh], l1 = LSE[(size_t)m * 24 + 8 + hh], l2 = LSE[(size_t)m * 24 + 16 + hh];
        const float mm = fmaxf(l0, fmaxf(l1, l2)); float e0 = __expf(l0 - mm), e1 = __expf(l1 - mm), e2 = __expf(l2 - mm); const float is = 1.f / (e0 + e1 + e2);
        e0 *= is; e1 *= is; e2 *= is;
        const bf16* o = OG + (size_t)m * 1536 + hh * 64 + ch * 8;
        f32x4 a0, a1, b0, b1, c0, c1; unpack8(*(const u32x4*)o, a0, a1); unpack8(*(const u32x4*)(o + 512), b0, b1); unpack8(*(const u32x4*)(o + 1024), c0, c1);
        *(u32x4*)(YA + (size_t)m * 512 + hh * 64 + ch * 8) = pack8(a0 * e0 + b0 * e1 + c0 * e2, a1 * e0 + b1 * e1 + c1 * e2);
    }
}

constexpr int GA_LB = 0, GA_QT = 33792, GA_KT = 51200, GA_KH = 68608, GA_VT = 87040, GA_AT = 123904, GA_LR = 133120, GA_WG = 137216, GA_BG = 145408, GA_QS = 145920;
__device__ __forceinline__ float log_sigmoid_(float x) { return fminf(x, 0.f) - log1pf(__expf(-fabsf(x))); }
__device__ __forceinline__ void gla_a_phase(Frame& F, const Args& args) {
    const int tid = F.tid, lane = F.lane, wid = F.wave, l31 = lane & 31, hi = lane >> 5;
    LAS unsigned char* lds = F.lds;
    LAS float* LB = (LAS float*)(lds + GA_LB); LAS float* LRs = (LAS float*)(lds + GA_LR); LAS float* WG = (LAS float*)(lds + GA_WG); LAS float* BG = (LAS float*)(lds + GA_BG); LAS float* QS = (LAS float*)(lds + GA_QS);
    bf16* QA = (bf16*)(F.ws + WS_QA); const bf16* KA = (const bf16*)(F.ws + WS_KA); bf16* VA = (bf16*)(F.ws + WS_VA);
    const float* LR = (const float*)(F.ws + WS_LR); bf16* DS = (bf16*)(F.ws + WS_DS); float* DEC = (float*)(F.ws + WS_DECAY);
#pragma unroll 1
    for (int it = 0;; ++it) {
        const int U = it * F.G + F.vcu; if (U >= 1024) break;
        const int bh = U >> 6, c = U & 63, b = bh >> 2, h = bh & 3; const size_t tok0 = (size_t)b * SEQ + c * 64;
        __syncthreads();
        if (tid < 256) *(LAS f32x4*)(LRs + tid * 4) = *(const f32x4*)(LR + tok0 * 16 + tid * 4);
        for (int i = tid; i < 2048; i += NTHR) WG[i] = args.in[6][(i >> 7) * 512 + h * 128 + (i & 127)];
        if (tid < 128) BG[tid] = args.in[7][h * 128 + tid];
        __syncthreads();
        {
            const int k = tid & 127, tq = tid >> 7; float wg[16];
#pragma unroll
            for (int j = 0; j < 16; ++j) wg[j] = WG[j * 128 + k];
            const float bg = BG[k]; float cs = 0.f;
#pragma unroll 4
            for (int tt = 0; tt < 16; ++tt) { const int t = tq * 16 + tt; float lg = bg;
#pragma unroll
                for (int j4 = 0; j4 < 4; ++j4) { const f32x4 l4 = *(const LAS f32x4*)(LRs + t * 16 + j4 * 4); lg += l4[0] * wg[4 * j4] + l4[1] * wg[4 * j4 + 1] + l4[2] * wg[4 * j4 + 2] + l4[3] * wg[4 * j4 + 3]; }
                cs += log_sigmoid_(lg) * (1.f / 16.f); LB[t * 132 + k] = cs; }
            QS[tq * 128 + k] = cs;
            __syncthreads();
            float off = 0.f;
#pragma unroll
            for (int q = 0; q < 3; ++q) off += (q < tq) ? QS[q * 128 + k] : 0.f;
            if (tq > 0) {
#pragma unroll 4
                for (int tt = 0; tt < 16; ++tt) LB[(tq * 16 + tt) * 132 + k] += off;
            }
        }
        __syncthreads();
        {
            const int t = lane; const size_t tok = tok0 + t;
#pragma unroll
            for (int p = 0; p < 2; ++p) {
                const int kc = wid * 2 + p;
                f32x4 q0, q1, k0, k1; unpack8(*(const u32x4*)(QA + tok * 512 + h * 128 + kc * 8), q0, q1); unpack8(*(const u32x4*)(KA + tok * 512 + h * 128 + kc * 8), k0, k1);
                const f32x4 b0 = *(const LAS f32x4*)(LB + t * 132 + kc * 8), b1 = *(const LAS f32x4*)(LB + t * 132 + kc * 8 + 4);
                const f32x4 e0 = *(const LAS f32x4*)(LB + 63 * 132 + kc * 8), e1 = *(const LAS f32x4*)(LB + 63 * 132 + kc * 8 + 4);
                f32x4 qt0, qt1, kt0, kt1, kh0, kh1;
#pragma unroll
                for (int j = 0; j < 4; ++j) {
                    qt0[j] = q0[j] * __expf(b0[j]); qt1[j] = q1[j] * __expf(b1[j]);
                    kt0[j] = k0[j] * __expf(-b0[j]); kt1[j] = k1[j] * __expf(-b1[j]);
                    kh0[j] = k0[j] * __expf(e0[j] - b0[j]); kh1[j] = k1[j] * __expf(e1[j] - b1[j]);
                }
                const u32x4 qw = pack8(qt0, qt1);
                *(LAS u32x4*)(lds + GA_QT + t * 272 + kc * 16) = qw; *(u32x4*)(QA + tok * 512 + h * 128 + kc * 8) = qw;
                *(LAS u32x4*)(lds + GA_KT + t * 272 + kc * 16) = pack8(kt0, kt1);
#pragma unroll
                for (int j = 0; j < 4; ++j) { *(LAS bf16*)(lds + GA_KH + (kc * 8 + j) * 144 + t * 2) = f2bf(kh0[j]); *(LAS bf16*)(lds + GA_KH + (kc * 8 + 4 + j) * 144 + t * 2) = f2bf(kh1[j]); }
            }
#pragma unroll
            for (int p = 0; p < 4; ++p) {
                const int vc = wid * 4 + p; const u32x4 vv = *(const u32x4*)(VA + tok * 1024 + h * 256 + vc * 8);
                const unsigned w[4] = {vv.x, vv.y, vv.z, vv.w};
#pragma unroll
                for (int j = 0; j < 4; ++j) { *(LAS bf16*)(lds + GA_VT + (vc * 8 + 2 * j) * 144 + t * 2) = (bf16)(w[j] & 0xffffu); *(LAS bf16*)(lds + GA_VT + (vc * 8 + 2 * j + 1) * 144 + t * 2) = (bf16)(w[j] >> 16); }
            }
            if (tid < 128) DEC[(size_t)U * 128 + tid] = __expf(LB[63 * 132 + tid]);
        }
        __syncthreads();
        if (wid < 4) {
            const int mt = wid >> 1, nt = wid & 1;
            f32x16 a = {0.f, 0.f, 0.f, 0.f, 0.f, 0.f, 0.f, 0.f, 0.f, 0.f, 0.f, 0.f, 0.f, 0.f, 0.f, 0.f};
#pragma unroll
            for (int kk = 0; kk < 8; ++kk) {
                const bf16x8 qf = *(const LAS bf16x8*)(lds + GA_QT + (32 * mt + l31) * 272 + kk * 32 + hi * 16);
                const bf16x8 kf = *(const LAS bf16x8*)(lds + GA_KT + (32 * nt + l31) * 272 + kk * 32 + hi * 16);
                a = __builtin_amdgcn_mfma_f32_32x32x16_bf16(qf, kf, a, 0, 0, 0);
            }
            const int s = 32 * nt + l31;
#pragma unroll
            for (int rr = 0; rr < 16; ++rr) { const int t = 32 * mt + crow(rr, hi); *(LAS bf16*)(lds + GA_AT + t * 144 + s * 2) = f2bf(t >= s ? a[rr] : 0.f); }
        }
        __syncthreads();
        {
            f32x16 a0 = {0.f, 0.f, 0.f, 0.f, 0.f, 0.f, 0.f, 0.f, 0.f, 0.f, 0.f, 0.f, 0.f, 0.f, 0.f, 0.f}, a1 = a0;
#pragma unroll
            for (int ks = 0; ks < 4; ++ks) {
                const bf16x8 vf = *(const LAS bf16x8*)(lds + GA_VT + (32 * wid + l31) * 144 + ks * 32 + hi * 16);
                const bf16x8 t0 = *(const LAS bf16x8*)(lds + GA_AT + l31 * 144 + ks * 32 + hi * 16);
                const bf16x8 t1 = *(const LAS bf16x8*)(lds + GA_AT + (32 + l31) * 144 + ks * 32 + hi * 16);
                a0 = __builtin_amdgcn_mfma_f32_32x32x16_bf16(vf, t0, a0, 0, 0, 0);
                a1 = __builtin_amdgcn_mfma_f32_32x32x16_bf16(vf, t1, a1, 0, 0, 0);
            }
            bf16* o0 = VA + (tok0 + l31) * 1024 + h * 256 + 32 * wid + 4 * hi; bf16* o1 = o0 + 32 * 1024;
#pragma unroll
            for (int a4 = 0; a4 < 4; ++a4) {
                u32x2 w0, w1; w0.x = pk2(a0[4 * a4], a0[4 * a4 + 1]); w0.y = pk2(a0[4 * a4 + 2], a0[4 * a4 + 3]); w1.x = pk2(a1[4 * a4], a1[4 * a4 + 1]); w1.y = pk2(a1[4 * a4 + 2], a1[4 * a4 + 3]);
                *(u32x2*)(o0 + 8 * a4) = w0; *(u32x2*)(o1 + 8 * a4) = w1;
            }
        }
        {
            f32x16 a[4];
#pragma unroll
            for (int mt = 0; mt < 4; ++mt) a[mt] = (f32x16){0.f, 0.f, 0.f, 0.f, 0.f, 0.f, 0.f, 0.f, 0.f, 0.f, 0.f, 0.f, 0.f, 0.f, 0.f, 0.f};
#pragma unroll
            for (int ks = 0; ks < 4; ++ks) {
                const bf16x8 vf = *(const LAS bf16x8*)(lds + GA_VT + (32 * wid + l31) * 144 + ks * 32 + hi * 16);
#pragma unroll
                for (int mt = 0; mt < 4; ++mt) { const bf16x8 kf = *(const LAS bf16x8*)(lds + GA_KH + (32 * mt + l31) * 144 + ks * 32 + hi * 16); a[mt] = __builtin_amdgcn_mfma_f32_32x32x16_bf16(kf, vf, a[mt], 0, 0, 0); }
            }
            bf16* d = DS + (size_t)U * 32768 + (size_t)(32 * wid + l31) * 128 + 4 * hi;
#pragma unroll
            for (int mt = 0; mt < 4; ++mt)
#pragma unroll
                for (int a4 = 0; a4 < 4; ++a4) { u32x2 w; w.x = pk2(a[mt][4 * a4], a[mt][4 * a4 + 1]); w.y = pk2(a[mt][4 * a4 + 2], a[mt][4 * a4 + 3]); *(u32x2*)(d + 32 * mt + 8 * a4) = w; }
        }
    }
    __syncthreads();
}
__device__ __forceinline__ void gla_scan_phase(Frame& F) {
    bf16* DS = (bf16*)(F.ws + WS_DS); const float* DEC = (const float*)(F.ws + WS_DECAY);
#pragma unroll 1
    for (int e4 = F.vcu * NTHR + F.tid; e4 < 16 * 8192; e4 += F.G * NTHR) {
        const int bh = e4 >> 13, rem = e4 & 8191; const size_t eo = (size_t)(rem >> 5) * 128 + (rem & 31) * 4;
        f32x4 s = {0.f, 0.f, 0.f, 0.f};
#pragma unroll 8
        for (int c = 0; c < 64; ++c) {
            const size_t U = (size_t)bh * 64 + c; u32x2* p = (u32x2*)(DS + U * 32768 + eo);
            const u32x2 w = *p; const f32x4 dc = *(const f32x4*)(DEC + U * 128 + (rem & 31) * 4);
            u32x2 o; o.x = pk2(s[0], s[1]); o.y = pk2(s[2], s[3]); *p = o;
            s[0] = s[0] * dc[0] + bflo(w.x); s[1] = s[1] * dc[1] + bfhi(w.x); s[2] = s[2] * dc[2] + bflo(w.y); s[3] = s[3] * dc[3] + bfhi(w.y);
        }
    }
}
__device__ __forceinline__ void gla_c_phase(Frame& F, const Args& args) {
    const int tid = F.tid, lane = F.lane, wid = F.wave, l31 = lane & 31, hi = lane >> 5;
    LAS unsigned char* lds = F.lds; LAS float* SS = (LAS float*)(lds + 20480);
    const bf16* QA = (const bf16*)(F.ws + WS_QA); const bf16* OI = (const bf16*)(F.ws + WS_VA); const bf16* RA = (const bf16*)(F.ws + WS_RA);
    const bf16* DS = (const bf16*)(F.ws + WS_DS); bf16* YG = (bf16*)(F.ws + WS_YGLA);
#pragma unroll 1
    for (int it = 0;; ++it) {
        const int U = it * F.G + F.vcu; if (U >= 1024) break;
        const int bh = U >> 6, c = U & 63, b = bh >> 2, h = bh & 3; const size_t tok0 = (size_t)b * SEQ + c * 64;
        __syncthreads();
#pragma unroll
        for (int p = 0; p < 2; ++p) { const int ch = tid + p * NTHR, t = ch >> 4, kc = ch & 15; *(LAS u32x4*)(lds + t * 272 + kc * 16) = *(const u32x4*)(QA + (tok0 + t) * 512 + h * 128 + kc * 8); }
        __syncthreads();
        f32x16 a0 = {0.f, 0.f, 0.f, 0.f, 0.f, 0.f, 0.f, 0.f, 0.f, 0.f, 0.f, 0.f, 0.f, 0.f, 0.f, 0.f}, a1 = a0;
        const bf16* srow = DS + (size_t)U * 32768 + (size_t)(32 * wid + l31) * 128 + hi * 8;
#pragma unroll
        for (int kk = 0; kk < 8; ++kk) {
            const bf16x8 sf = *(const bf16x8*)(srow + kk * 16);
            const bf16x8 q0 = *(const LAS bf16x8*)(lds + l31 * 272 + kk * 32 + hi * 16);
            const bf16x8 q1 = *(const LAS bf16x8*)(lds + (32 + l31) * 272 + kk * 32 + hi * 16);
            a0 = __builtin_amdgcn_mfma_f32_32x32x16_bf16(sf, q0, a0, 0, 0, 0);
            a1 = __builtin_amdgcn_mfma_f32_32x32x16_bf16(sf, q1, a1, 0, 0, 0);
        }
        const size_t e0 = (tok0 + l31) * 1024 + h * 256 + 32 * wid + 4 * hi, e1 = e0 + 32 * 1024;
        float q0s = 0.f, q1s = 0.f;
#pragma unroll
        for (int a4 = 0; a4 < 4; ++a4) {
            const u32x2 w0 = *(const u32x2*)(OI + e0 + 8 * a4), w1 = *(const u32x2*)(OI + e1 + 8 * a4);
            a0[4 * a4] += bflo(w0.x); a0[4 * a4 + 1] += bfhi(w0.x); a0[4 * a4 + 2] += bflo(w0.y); a0[4 * a4 + 3] += bfhi(w0.y);
            a1[4 * a4] += bflo(w1.x); a1[4 * a4 + 1] += bfhi(w1.x); a1[4 * a4 + 2] += bflo(w1.y); a1[4 * a4 + 3] += bfhi(w1.y);
#pragma unroll
            for (int j = 0; j < 4; ++j) { q0s += a0[4 * a4 + j] * a0[4 * a4 + j]; q1s += a1[4 * a4 + j] * a1[4 * a4 + j]; }
        }
        q0s += __shfl_xor(q0s, 32); q1s += __shfl_xor(q1s, 32);
        if (hi == 0) { SS[wid * 64 + l31] = q0s; SS[wid * 64 + 32 + l31] = q1s; }
        __syncthreads();
        float t0 = 0.f, t1 = 0.f;
#pragma unroll
        for (int w = 0; w < 8; ++w) { t0 += SS[w * 64 + l31]; t1 += SS[w * 64 + 32 + l31]; }
        const float r0 = rsqrtf(t0 * (1.f / 256.f) + LN_EPS), r1 = rsqrtf(t1 * (1.f / 256.f) + LN_EPS);
        const float* ng = args.in[8] + h * 256 + 32 * wid + 4 * hi;
#pragma unroll
        for (int a4 = 0; a4 < 4; ++a4) {
            const f32x4 g4 = *(const f32x4*)(ng + 8 * a4);
            const u32x2 s0 = *(const u32x2*)(RA + e0 + 8 * a4), s1 = *(const u32x2*)(RA + e1 + 8 * a4);
            u32x2 w0, w1;
            w0.x = pk2(a0[4 * a4] * r0 * g4[0] * bflo(s0.x), a0[4 * a4 + 1] * r0 * g4[1] * bfhi(s0.x)); w0.y = pk2(a0[4 * a4 + 2] * r0 * g4[2] * bflo(s0.y), a0[4 * a4 + 3] * r0 * g4[3] * bfhi(s0.y));
            w1.x = pk2(a1[4 * a4] * r1 * g4[0] * bflo(s1.x), a1[4 * a4 + 1] * r1 * g4[1] * bfhi(s1.x)); w1.y = pk2(a1[4 * a4 + 2] * r1 * g4[2] * bflo(s1.y), a1[4 * a4 + 3] * r1 * g4[3] * bfhi(s1.y));
            *(u32x2*)(YG + e0 + 8 * a4) = w0; *(u32x2*)(YG + e1 + 8 * a4) = w1;
        }
    }
    __syncthreads();
}

__device__ __forceinline__ void ln1_router_phase(Frame& F, const Args& args) {
    const int tid = F.tid, lane = F.lane;
    LAS float* WR = (LAS float*)F.lds;
    for (int i = tid; i < 1024 * 36; i += NTHR) { const int k = i / 36, c = i % 36; WR[i] = (c < 4) ? args.in[14][k * 4 + c] : args.in[16][k * 32 + c - 4]; }
    __syncthreads();
    const int gw = F.vcu * NWAVES + F.wave, NGW = F.G * NWAVES;
    float* X1 = F.out; const float* mods = (const float*)(F.ws + WS_MODS); bf16* U2 = (bf16*)(F.ws + WS_U2);
    unsigned* cnt = (unsigned*)(F.ws + WS_CTL) + CW_CNT; unsigned* lst = (unsigned*)(F.ws + WS_LST); float* lstw = (float*)(F.ws + WS_LSTW);
#pragma unroll 1
    for (int m = gw; m < NTOK; m += NGW) {
        const int b = m >> 12; float* xr = X1 + (size_t)m * 1024;
        float x[16]; float s = 0.f;
#pragma unroll
        for (int i = 0; i < 16; ++i) { x[i] = xr[lane + 64 * i]; s += x[i]; }
        const float mean = wave_sum(s) * (1.f / 1024.f); float s2 = 0.f;
#pragma unroll
        for (int i = 0; i < 16; ++i) { x[i] -= mean; s2 += x[i] * x[i]; }
        const float rstd = rsqrtf(wave_sum(s2) * (1.f / 1024.f) + LN_EPS);
        float acc[36];
#pragma unroll
        for (int c = 0; c < 36; ++c) acc[c] = 0.f;
        int lane_ = lane; asm volatile("" : "+v"(lane_));
#pragma unroll
        for (int i = 0; i < 16; ++i) {
            asm volatile("" ::: "memory");
            const unsigned col = (unsigned)lane_ + 64u * i;
            const float x1 = x[i] * rstd * args.in[12][col] + args.in[13][col];
            xr[col] = x1;
            const float u2 = x1 * (1.f + mods[b * 6144 + 4 * 1024 + col]) + mods[b * 6144 + 3 * 1024 + col];
            U2[(size_t)m * 1024 + col] = f2bf(u2);
#pragma unroll
            for (int c4 = 0; c4 < 9; ++c4) { const f32x4 w = *(const LAS f32x4*)(WR + col * 36 + c4 * 4); acc[4 * c4] += u2 * w[0]; acc[4 * c4 + 1] += u2 * w[1]; acc[4 * c4 + 2] += u2 * w[2]; acc[4 * c4 + 3] += u2 * w[3]; }
        }
#pragma unroll
        for (int c = 0; c < 36; ++c) { acc[c] = wave_sum(acc[c]); if ((c & 3) == 3) asm volatile("" : "+v"(acc[c - 3]), "+v"(acc[c - 2]), "+v"(acc[c - 1]), "+v"(acc[c])); }
        float gl[4];
#pragma unroll
        for (int j = 0; j < 4; ++j) gl[j] = acc[j] + args.in[15][j];
        int gi = 0; float gm = gl[0];
#pragma unroll
        for (int j = 1; j < 4; ++j) if (gl[j] > gm) { gm = gl[j]; gi = j; }
        float gs = 0.f;
#pragma unroll
        for (int j = 0; j < 4; ++j) gs += __expf(gl[j] - gm);
        const float gval = 1.f / gs;
        float el[8];
#pragma unroll
        for (int j = 0; j < 8; ++j) { const float v = (gi == 0) ? acc[4 + j] : (gi == 1) ? acc[12 + j] : (gi == 2) ? acc[20 + j] : acc[28 + j]; el[j] = v + args.in[17][gi * 8 + j]; }
        int i1 = 0; float v1 = el[0];
#pragma unroll
        for (int j = 1; j < 8; ++j) if (el[j] > v1) { v1 = el[j]; i1 = j; }
        int i2 = -1; float v2 = -INFINITY;
#pragma unroll
        for (int j = 0; j < 8; ++j) if (j != i1 && el[j] > v2) { v2 = el[j]; i2 = j; }
        const float w1 = 1.f / (1.f + __expf(v2 - v1)), w2 = 1.f - w1;
        if (lane == 0) {
            const int E1 = gi * 8 + i1, E2 = gi * 8 + i2;
            const unsigned p1 = atomicAdd(&cnt[E1], 1u), p2 = atomicAdd(&cnt[E2], 1u);
            lst[(size_t)E1 * NTOK + p1] = (unsigned)m * 2u; lstw[(size_t)E1 * NTOK + p1] = gval * w1;
            lst[(size_t)E2 * NTOK + p2] = (unsigned)m * 2u + 1u; lstw[(size_t)E2 * NTOK + p2] = gval * w2;
        }
    }
    __syncthreads();
}
__device__ __forceinline__ void moe_tiles(Frame& F) {
    LAS int* ts = (LAS int*)(F.lds + LDS_TS);
    __syncthreads();
    if (F.tid == 0) { const unsigned* cnt = (const unsigned*)(F.ws + WS_CTL) + CW_CNT; int a = 0; for (int e = 0; e < 32; ++e) { ts[e] = a; a += (int)((__hip_atomic_load(cnt + e, __ATOMIC_RELAXED, __HIP_MEMORY_SCOPE_AGENT) + 255u) >> 8); } ts[32] = a; }
    __syncthreads();
}
__device__ __forceinline__ void final_phase(Frame& F, const Args& args) {
    const int gw = F.vcu * NWAVES + F.wave, NGW = F.G * NWAVES, lane = F.lane;
    const float* mods = (const float*)(F.ws + WS_MODS); const bf16* Y = (const bf16*)(F.ws + WS_Y);
#pragma unroll 1
    for (int m = gw; m < NTOK; m += NGW) {
        const int b = m >> 12; f32x4* xr = (f32x4*)(F.out + (size_t)m * 1024) + lane;
        const f32x4* g2 = (const f32x4*)(mods + b * 6144 + 5 * 1024) + lane;
        const u32x2* y0 = (const u32x2*)(Y + (size_t)m * 1024) + lane; const u32x2* y1 = (const u32x2*)(Y + ((size_t)NTOK + m) * 1024) + lane;
        f32x4 v[4]; float s = 0.f;
#pragma unroll
        for (int j = 0; j < 4; ++j) { const u32x2 a = y0[64 * j], c = y1[64 * j];
            const f32x4 y = (f32x4){bflo(a.x) + bflo(c.x), bfhi(a.x) + bfhi(c.x), bflo(a.y) + bflo(c.y), bfhi(a.y) + bfhi(c.y)};
            v[j] = xr[64 * j] * ALPHA + g2[64 * j] * y; s += (v[j][0] + v[j][1]) + (v[j][2] + v[j][3]); }
        const float mean = wave_sum(s) * (1.f / 1024.f); float s2 = 0.f;
#pragma unroll
        for (int j = 0; j < 4; ++j) { v[j] = v[j] - mean; s2 += (v[j][0] * v[j][0] + v[j][1] * v[j][1]) + (v[j][2] * v[j][2] + v[j][3] * v[j][3]); }
        const float rstd = rsqrtf(wave_sum(s2) * (1.f / 1024.f) + LN_EPS);
        const f32x4* lg = (const f32x4*)args.in[21] + lane; const f32x4* lb = (const f32x4*)args.in[22] + lane;
#pragma unroll
        for (int j = 0; j < 4; ++j) xr[64 * j] = v[j] * rstd * lg[64 * j] + lb[64 * j];
    }
}

#if NAIVE_ATTN
__device__ __forceinline__ void attn_naive(Frame& F) {
    const int gw = F.vcu * NWAVES + F.wave, NGW = F.G * NWAVES, lane = F.lane;
    LAS float* pl = (LAS float*)(F.lds) + F.wave * 256;
    bf16* QD = (bf16*)(F.ws + WS_QD); const bf16* KD = (const bf16*)(F.ws + WS_KD); const bf16* VD = (const bf16*)(F.ws + WS_VD);
    float* LSE = (float*)(F.ws + WS_LSE); const float* BT = (const float*)(F.ws + WS_BTAB);
#pragma unroll 1
    for (int w = gw; w < NTOK * 24; w += NGW) {
        const int m = w / 24, gh = w % 24, g = gh >> 3, dil = 1 << (2 * g), b = m >> 12, s = m & 4095;
        const bf16* q = QD + (size_t)m * 1536 + gh * 64;
        float sc[3]; float mx = -INFINITY;
#pragma unroll
        for (int p = 0; p < 3; ++p) {
            const int mm = lane + 64 * p; const int sk = s - mm * dil; float v = -INFINITY;
            if (mm <= 128 && sk >= 0) { const bf16* k = KD + (size_t)(b * SEQ + sk) * 1536 + gh * 64; float d = 0.f; for (int e = 0; e < 64; ++e) d += bf2f(q[e]) * bf2f(k[e]); v = d + BT[gh * 132 + mm]; }
            sc[p] = v; mx = fmaxf(mx, v);
        }
#pragma unroll
        for (int o = 1; o < 64; o <<= 1) mx = fmaxf(mx, __shfl_xor(mx, o));
        float sum = 0.f;
#pragma unroll
        for (int p = 0; p < 3; ++p) { const float e = __expf(sc[p] - mx); if (lane + 64 * p < 256) pl[lane + 64 * p] = e; sum += e; }
        sum = wave_sum(sum);
        LDS_WAIT();
        float o = 0.f;
        for (int mm = 0; mm <= 128; ++mm) { const int sk = s - mm * dil; if (sk >= 0) o += pl[mm] * bf2f(VD[(size_t)(b * SEQ + sk) * 1536 + gh * 64 + lane]); }
        LDS_WAIT();
        QD[(size_t)m * 1536 + gh * 64 + lane] = f2bf(o / sum);
        if (lane == 0) LSE[(size_t)m * 24 + gh] = mx + __logf(sum);
    }
    __syncthreads();
}
#endif
#if NAIVE_GLA || DBG_GLA_DIFF
__device__ __forceinline__ void gla_naive(Frame& F, const Args& args) {
    const int tid = F.tid;
    LAS float* A = (LAS float*)F.lds;
    LAS float* Qs = A + 8192; LAS float* Ks = Qs + 8192; LAS float* Vs = Ks + 8192;
    LAS float* Os = Vs + 1024;
    const bf16* QA = (const bf16*)(F.ws + WS_QA); const bf16* KA = (const bf16*)(F.ws + WS_KA); const bf16* VA = (const bf16*)(F.ws + WS_VA);
    const float* LR = (const float*)(F.ws + WS_LR); float* OF = (float*)(F.ws + WS_DS);
    const int U = F.vcu; if (U < 256) {
    const int bh = U >> 4, vt = U & 15, b = bh >> 2, h = bh & 3;
    float st[8];
#pragma unroll
    for (int j = 0; j < 8; ++j) st[j] = 0.f;
    const int v = tid & 15, kg = (tid >> 4) & 15;
    for (int c = 0; c < 64; ++c) {
        const size_t tok0 = (size_t)b * SEQ + c * 64;
        __syncthreads();
        for (int i = tid; i < 8192; i += NTHR) { const int t = i >> 7, k = i & 127; float lg = args.in[7][h * 128 + k];
            for (int j = 0; j < 16; ++j) lg += LR[(tok0 + t) * 16 + j] * args.in[6][j * 512 + h * 128 + k];
            A[i] = __expf(log_sigmoid_(lg) * (1.f / 16.f)); Qs[i] = bf2f(QA[(tok0 + t) * 512 + h * 128 + k]); Ks[i] = bf2f(KA[(tok0 + t) * 512 + h * 128 + k]); }
        for (int i = tid; i < 1024; i += NTHR) { Vs[i] = bf2f(VA[(tok0 + (i >> 4)) * 1024 + h * 256 + vt * 16 + (i & 15)]); Os[i] = 0.f; }
        __syncthreads();
        if (tid < 256) {
            for (int t = 0; t < 64; ++t) { const float vv = Vs[t * 16 + v]; float o = 0.f;
#pragma unroll
                for (int j = 0; j < 8; ++j) { const int k = kg * 8 + j; st[j] = st[j] * A[t * 128 + k] + Ks[t * 128 + k] * vv; o += Qs[t * 128 + k] * st[j]; }
                o += __shfl_xor(o, 16); o += __shfl_xor(o, 32);
                if ((kg & 3) == 0) Os[(tid >> 6) * 1024 + t * 16 + v] = o;
            }
        }
        __syncthreads();
        for (int i = tid; i < 1024; i += NTHR) OF[(tok0 + (i >> 4)) * 1024 + h * 256 + vt * 16 + (i & 15)] = (Os[i] + Os[1024 + i]) + (Os[2048 + i] + Os[3072 + i]);
    }
    }
    __syncthreads();
}
__device__ __forceinline__ void gla_naive_norm(Frame& F, const Args& args, size_t ws_out = WS_YGLA) {
    const int gw = F.vcu * NWAVES + F.wave, NGW = F.G * NWAVES, lane = F.lane;
    const float* OF = (const float*)(F.ws + WS_DS); const bf16* RA = (const bf16*)(F.ws + WS_RA); bf16* YG = (bf16*)(F.ws + ws_out);
#pragma unroll 1
    for (int w = gw; w < NTOK * 4; w += NGW) {
        const size_t e = (size_t)(w >> 2) * 1024 + (w & 3) * 256 + lane * 4; const f32x4 o = *(const f32x4*)(OF + e);
        const float ss = wave_sum(o[0] * o[0] + o[1] * o[1] + o[2] * o[2] + o[3] * o[3]); const float rs = rsqrtf(ss * (1.f / 256.f) + LN_EPS);
        const float* ng = args.in[8] + (w & 3) * 256 + lane * 4;
#pragma unroll
        for (int j = 0; j < 4; ++j) YG[e + j] = f2bf(o[j] * rs * ng[j] * bf2f(RA[e + j]));
    }
}
#endif

enum { PH_P0 = 0, PH_P0B, PH_INPROJ, PH_ATTN, PH_GLAA, PH_SCAN, PH_GLAC, PH_PROJ, PH_OUT, PH_LN1, PH_MOE1, PH_MOE2, PH_FINAL, NPH };

__global__ void __launch_bounds__(NTHR, 2) mega_fwd(Args args) {
    extern __shared__ __attribute__((aligned(16))) unsigned char lds_raw[];
    Frame F;
    F.lds = (LAS unsigned char*)lds_raw;
    F.tid = threadIdx.x; F.lane = F.tid & 63; F.wave = __builtin_amdgcn_readfirstlane(F.tid >> 6);
    F.G = gridDim.x; { const int bx = blockIdx.x; F.vcu = (F.G % 8 == 0) ? (bx % 8) * (F.G / 8) + bx / 8 : bx; }
    F.ws = args.ws; F.out = args.out;
    for (int u = F.tid; u < (LDS_BYTES - LDSCTL_OFF) / 4; u += NTHR) ((LAS unsigned*)(F.lds + LDSCTL_OFF))[u] = 0u;
    __syncthreads();
    const int lo = args.ph_lo, hi = args.ph_hi;
    XcdBarrier bar; bar.bar = (unsigned*)(F.ws + WS_CTL) + CW_BAR; bar.x = 0; bar.st = nullptr;
    if (hi - lo > 1) bar = xcd_barrier_post((unsigned*)(F.ws + WS_CTL) + CW_BAR, (volatile LAS unsigned*)(F.lds + LDSCTL_OFF));
#ifndef PHASE_MASK
#define PHASE_MASK 0xFFFF
#endif
#define IN(k) (((PHASE_MASK >> (k)) & 1) && lo <= (k) && (k) < hi)
#define SEAM(k) do { if (IN(k) && IN((k) + 1)) xcd_barrier(bar); } while (0)
    unsigned char* ws = F.ws;
    bf16* GA = (bf16*)F.out; bf16* GD = GA + (size_t)NTOK * 1024;

    if (IN(PH_P0)) { frame_refresh(F); p0_phase(F, args); } SEAM(PH_P0);
    if (IN(PH_P0B)) { frame_refresh(F); p0b_phase(F, args); } SEAM(PH_P0B);
    if (IN(PH_INPROJ)) { frame_refresh(F);
        pg8::DenseOrder S; S.init(NTOK, INPAD, 1024, F.G, (int)blockIdx.x);
        run_gemm(F, (const bf16*)(ws + WS_U), (const bf16*)(ws + WS_WIN), 1024, S, EpiInProj{ws, GA, GD});
    } SEAM(PH_INPROJ);
    if (IN(PH_ATTN)) { frame_refresh(F);
#if NAIVE_ATTN
        attn_naive(F);
#else
        attn_phase(F);
#endif
    } SEAM(PH_ATTN);
    if (IN(PH_GLAA)) { frame_refresh(F);
#if NAIVE_GLA
        gla_naive(F, args);
#else
        gla_a_phase(F, args);
#endif
        combine_phase(F);
    } SEAM(PH_GLAA);
    if (IN(PH_SCAN)) { frame_refresh(F);
#if !NAIVE_GLA
        gla_scan_phase(F);
#endif
    } SEAM(PH_SCAN);
    if (IN(PH_GLAC)) { frame_refresh(F);
#if NAIVE_GLA
        gla_naive_norm(F, args);
#else
        gla_c_phase(F, args);
#endif
    } SEAM(PH_GLAC);
    if (IN(PH_PROJ)) { frame_refresh(F);
        pg8::DenseOrder S; S.init(NTOK, 1024, 512, F.G, (int)blockIdx.x);
        run_gemm(F, (const bf16*)(ws + WS_YATT), (const bf16*)(ws + WS_WPA), 512, S, EpiProjA{GD, (bf16*)(ws + WS_TT)});
        VM_WAIT(); __syncthreads();
        pg8::DenseOrder S2; S2.init(NTOK, 1024, 1024, F.G, (int)blockIdx.x);
        run_gemm(F, (const bf16*)(ws + WS_YGLA), (const bf16*)(ws + WS_WPG), 1024, S2, EpiProjG{GA, (const bf16*)(ws + WS_TT), (bf16*)(ws + WS_MERGED)});
        convert_experts(F, args);
    } SEAM(PH_PROJ);
    if (IN(PH_OUT)) { frame_refresh(F);
        pg8::DenseOrder S; S.init(NTOK, 1024, 1024, F.G, (int)blockIdx.x);
        run_gemm(F, (const bf16*)(ws + WS_MERGED), (const bf16*)(ws + WS_WOUT), 1024, S, EpiOut{args.in[0], (const float*)(ws + WS_MODS), F.out});
    } SEAM(PH_OUT);
    if (IN(PH_LN1)) { frame_refresh(F); ln1_router_phase(F, args); } SEAM(PH_LN1);
    if (IN(PH_MOE1)) { frame_refresh(F);
        moe_tiles(F);
        MoeOrder S{(const LAS int*)(F.lds + LDS_TS), (const unsigned*)(ws + WS_CTL) + CW_CNT, (const unsigned*)(ws + WS_LST), F.G, F.vcu, 0};
        run_gemm(F, (const bf16*)(ws + WS_U2), (const bf16*)(ws + WS_WGU), 1024, S, EpiMoeUp{(bf16*)(ws + WS_H)});
    } SEAM(PH_MOE1);
    if (IN(PH_MOE2)) { frame_refresh(F);
        moe_tiles(F);
        MoeOrder S{(const LAS int*)(F.lds + LDS_TS), (const unsigned*)(ws + WS_CTL) + CW_CNT, (const unsigned*)(ws + WS_LST), F.G, F.vcu, 1};
        run_gemm(F, (const bf16*)(ws + WS_H), (const bf16*)(ws + WS_WDN), 512, S, EpiMoeDown{(const unsigned*)(ws + WS_CTL) + CW_CNT, (const unsigned*)(ws + WS_LST), (const float*)(ws + WS_LSTW), (bf16*)(ws + WS_Y)});
    } SEAM(PH_MOE2);
    if (IN(PH_FINAL)) { frame_refresh(F); final_phase(F, args); }
#if DBG_GLA_DIFF
    if (lo == 13) { frame_refresh(F); gla_naive(F, args); }
    if (lo == 14) { frame_refresh(F); gla_naive_norm(F, args, WS_TT); }
    if (lo == 15) { frame_refresh(F);
        const bf16* ya = (const bf16*)(ws + DBG_SRC);
        for (size_t i = (size_t)blockIdx.x * NTHR + F.tid; i < (size_t)NTOK * 1024; i += (size_t)F.G * NTHR) { float d = bf2f(ya[i]); if (!(fabsf(d) < 1e30f)) d = 1e4f; F.out[i] = d; } }
#endif
#undef IN
#undef SEAM
}

extern "C" void kernel_launch(void* const* d_in, const int* in_sizes, int n_in, void* d_out, int out_size, void* d_ws, size_t ws_size, hipStream_t stream) {
    static int grid = 0;
    if (grid == 0) {
        if (n_in != 23 || out_size != NTOK * D || ws_size < WS_END) { fprintf(stderr, "kernel_launch: unexpected shapes (n_in %d out %d ws %zu, need %zu)\n", n_in, out_size, ws_size, (size_t)WS_END); grid = -1; return; }
        int dev = 0, cus = 0;
        if (hipGetDevice(&dev) != hipSuccess || hipDeviceGetAttribute(&cus, hipDeviceAttributeMultiprocessorCount, dev) != hipSuccess) { grid = -1; return; }
        if (hipFuncSetAttribute((const void*)mega_fwd, hipFuncAttributeMaxDynamicSharedMemorySize, LDS_BYTES) != hipSuccess) { fprintf(stderr, "kernel_launch: hipFuncSetAttribute failed\n"); grid = -1; return; }
        int per_cu = 0;
        if (hipOccupancyMaxActiveBlocksPerMultiprocessor(&per_cu, (const void*)mega_fwd, NTHR, LDS_BYTES) != hipSuccess || per_cu < 1) fprintf(stderr, "kernel_launch: occupancy query reports %d\n", per_cu);
        (void)hipGetLastError();
        grid = cus - (cus % 8);
        if (grid <= 0) grid = cus;
    }
    if (grid < 0) return;
    (void)hipMemsetAsync((char*)d_ws + WS_CTL, 0, CTL_ZERO_BYTES, stream);
    Args a{};
    for (int i = 0; i < 23; ++i) a.in[i] = (const float*)d_in[i];
    a.out = (float*)d_out; a.ws = (unsigned char*)d_ws;
#if DBG_GLA_DIFF
    { const int seq[] = DBG_SEQ;
      for (int k = 0; k < (int)(sizeof(seq) / sizeof(int)); ++k) { a.ph_lo = seq[k]; a.ph_hi = seq[k] + 1; hipLaunchKernelGGL(mega_fwd, dim3(grid), dim3(NTHR), LDS_BYTES, stream, a); } }
#elif MK_MULTI
    for (int p = 0; p < DBG_NPH; ++p) { a.ph_lo = p; a.ph_hi = p + 1; hipLaunchKernelGGL(mega_fwd, dim3(grid), dim3(NTHR), LDS_BYTES, stream, a); }
#else
    a.ph_lo = 0; a.ph_hi = NPH;
    hipLaunchKernelGGL(mega_fwd, dim3(grid), dim3(NTHR), LDS_BYTES, stream, a);
#endif
}
```

```cpp
#include <hip/hip_runtime.h>
#include <cstdio>
#include <cstdint>

#ifndef MK_MULTI
#define MK_MULTI 0
#endif
#ifndef MULTI_SEQ
#define MULTI_SEQ {0, 1, 2, 3, 4, 5, 6, 7, 8, 9, 10, 11, 12}
#endif
#ifndef DBG_GLA_DIFF
#define DBG_GLA_DIFF 0
#define DBG_SEQ {0, 1, 2, 3, 4, 15}
#define DBG_SRC WS_DS
#endif
#ifndef NAIVE_GEMM
#define NAIVE_GEMM 0
#endif
#ifndef NAIVE_ATTN
#define NAIVE_ATTN 0
#endif
#ifndef NAIVE_GLA
#define NAIVE_GLA 0
#endif

#define GAS __attribute__((address_space(1)))
#define LAS __attribute__((address_space(3)))
typedef unsigned short bf16;
typedef short bf16x8 __attribute__((ext_vector_type(8)));
typedef short s16x4 __attribute__((ext_vector_type(4)));
typedef float f32x4 __attribute__((ext_vector_type(4)));
typedef float f32x16 __attribute__((ext_vector_type(16)));
typedef unsigned u32x4 __attribute__((ext_vector_type(4)));
typedef unsigned u32x2 __attribute__((ext_vector_type(2)));

constexpr int NB = 4, SEQ = 4096, NTOK = NB * SEQ, D = 1024;
constexpr int NWAVES = 8, NTHR = 512;
constexpr int INCOLS = 9744, INPAD = 9984;
constexpr float LN_EPS = 1e-5f;
constexpr float ALPHA = 1.189207115002721f;
constexpr int C_QA = 0, C_KA = 512, C_VA = 1024, C_RA = 2048, C_QD = 3072, C_KD = 4608, C_VD = 6144, C_GA = 7680, C_GD = 8704, C_LR = 9728;

constexpr size_t MiB = 1u << 20;
constexpr size_t WS_CTL = 0, CTL_ZERO_BYTES = 256 * 1024;
constexpr size_t WS_MODS = 1 * MiB;
constexpr size_t WS_BTAB = WS_MODS + 128 * 1024;
constexpr size_t WS_WIN = 2 * MiB;
constexpr size_t WS_WPG = 22 * MiB, WS_WPA = 24 * MiB, WS_WOUT = 25 * MiB;
constexpr size_t WS_LR = 27 * MiB;
constexpr size_t WS_LSE = 28 * MiB;
constexpr size_t WS_DECAY = 318 * MiB;
constexpr size_t WS_QA = 30 * MiB, WS_KA = 46 * MiB, WS_VA = 62 * MiB, WS_RA = 94 * MiB;
constexpr size_t WS_QD = 126 * MiB, WS_KD = 174 * MiB, WS_VD = 222 * MiB;
constexpr size_t WS_U = 270 * MiB;
constexpr size_t WS_YGLA = 270 * MiB, WS_YATT = 302 * MiB;
constexpr size_t WS_DS = 174 * MiB;
constexpr size_t WS_MERGED = 30 * MiB;
constexpr size_t WS_T = 222 * MiB;
constexpr size_t WS_TT = 238 * MiB;
constexpr size_t WS_WGU = 126 * MiB;
constexpr size_t WS_WDN = 190 * MiB;
constexpr size_t WS_U2 = 62 * MiB;
constexpr size_t WS_LST = 94 * MiB;
constexpr size_t WS_LSTW = 96 * MiB;
constexpr size_t WS_H = 222 * MiB;
constexpr size_t WS_Y = 262 * MiB;
constexpr size_t WS_END = 326 * MiB;

constexpr int CW_CNT = 8192, CNT_STRIDE = 64;
constexpr int CW_BAR = 1024;

constexpr int LDS_BYTES = 163840;
constexpr int LDSCTL_OFF = 157696;
constexpr int LDS_TS = LDSCTL_OFF + 64;

#define LDS_WAIT() asm volatile("s_waitcnt lgkmcnt(0)" ::: "memory")
#define VM_WAIT() asm volatile("s_waitcnt vmcnt(0)" ::: "memory")

typedef float f32x2_t __attribute__((ext_vector_type(2))); typedef __bf16 bf16x2_t __attribute__((ext_vector_type(2)));
__device__ __forceinline__ unsigned pk2(float lo, float hi) { f32x2_t v = {lo, hi}; bf16x2_t b = __builtin_convertvector(v, bf16x2_t); return __builtin_bit_cast(unsigned, b); }
__device__ __forceinline__ bf16 f2bf(float x) { return (bf16)(pk2(x, 0.f) & 0xffffu); }
__device__ __forceinline__ float bf2f(unsigned short u) { return __uint_as_float(((unsigned)u) << 16); }
__device__ __forceinline__ float bflo(unsigned w) { return __uint_as_float(w << 16); }
__device__ __forceinline__ float bfhi(unsigned w) { return __uint_as_float(w & 0xffff0000u); }
__device__ __forceinline__ float sigmoidf_(float x) { return 1.f / (1.f + __expf(-x)); }
__device__ __forceinline__ float siluf_(float x) { return x / (1.f + __expf(-x)); }
__device__ __forceinline__ float wave_sum(float v) {
#pragma unroll
    for (int o = 1; o < 64; o <<= 1) v += __shfl_xor(v, o);
    return v;
}
__device__ __forceinline__ int crow(int r, int hi) { return (r & 3) + 8 * (r >> 2) + 4 * hi; }

#define XB_TMO      128
#define XB_XCNT(j)  (256  + 64 * (j))
#define XB_XSUB(j)  (1280 + 64 * (j))
#define XB_XGEN(j)  (2304 + 64 * (j))
#define XB_TOP      3328
#define XB_TOPGEN   3392
#define XCD_BAR_WORDS 3456
#define XB_SPIN_CAP (1u << 18)
__device__ __forceinline__ unsigned xb_ld(unsigned* p)              { return __hip_atomic_load(p, __ATOMIC_RELAXED, __HIP_MEMORY_SCOPE_AGENT); }
__device__ __forceinline__ unsigned xb_add(unsigned* p, unsigned v) { return __hip_atomic_fetch_add(p, v, __ATOMIC_RELAXED, __HIP_MEMORY_SCOPE_AGENT); }
__device__ __forceinline__ unsigned xb_xcc_id() { return (unsigned)__builtin_amdgcn_s_getreg((3 << 11) | 20) & 0xFu; }
#define XB_SPIN(cond, bar) do { unsigned _sp = 0; while (cond) { __builtin_amdgcn_s_sleep(1); \
    if ((++_sp & 255u) == 0u) { if (xb_ld(&(bar)[XB_TMO])) break; if (_sp > XB_SPIN_CAP) { atomicAdd(&(bar)[XB_TMO], 1u); break; } } } } while (0)
struct XcdBarrier { unsigned* bar; unsigned x; volatile LAS unsigned* st; };
__device__ __forceinline__ XcdBarrier xcd_barrier_post(unsigned* bar, volatile LAS unsigned* st) {
    XcdBarrier b; b.bar = bar; b.x = xb_xcc_id(); b.st = st;
    if (threadIdx.x == 0) (void)xb_add(&bar[XB_XCNT(b.x)], 1u);
    return b;
}
__device__ __forceinline__ void xcd_barrier_complete(unsigned* bar, unsigned x, unsigned& nloc, unsigned& nx) {
    const unsigned G = gridDim.x * gridDim.y * gridDim.z;
    unsigned sum, cnt, mine, sp = 0u;
    for (;;) {
        sum = 0u; cnt = 0u; mine = 0u;
#pragma unroll
        for (unsigned j = 0; j < 16; ++j) { const unsigned c = xb_ld(&bar[XB_XCNT(j)]); sum += c; cnt += (c > 0u) ? 1u : 0u; mine = (j == x) ? c : mine; }
        if (sum == G) break;
        __builtin_amdgcn_s_sleep(1);
        if ((++sp & 255u) == 0u) { if (xb_ld(&bar[XB_TMO])) break; if (sp > XB_SPIN_CAP) { atomicAdd(&bar[XB_TMO], 1u); break; } }
    }
    nloc = mine > 0u ? mine : 1u; nx = cnt > 0u ? cnt : 1u;
}
__device__ __forceinline__ void xcd_barrier(const XcdBarrier& b) {
    asm volatile("s_waitcnt vmcnt(0)" ::: "memory");
    __syncthreads();
    if (threadIdx.x == 0) {
        unsigned* bar = b.bar;
        __builtin_amdgcn_s_waitcnt(0);
        unsigned nloc = b.st[0], nx = b.st[1];
        if (nloc == 0u) { xcd_barrier_complete(bar, b.x, nloc, nx); b.st[0] = nloc; b.st[1] = nx; }
        const unsigned old = xb_add(&bar[XB_XSUB(b.x)], 1u);
        const unsigned gen = old / nloc;
        if (old + 1u == (gen + 1u) * nloc) {
            __builtin_amdgcn_fence(__ATOMIC_RELEASE, "agent");
            asm volatile("s_waitcnt vmcnt(0)" ::: "memory");
            const unsigned og = xb_add(&bar[XB_TOP], 1u);
            const unsigned tg = og / nx;
            if (og + 1u == (tg + 1u) * nx) xb_add(&bar[XB_TOPGEN], 1u);
            else XB_SPIN(xb_ld(&bar[XB_TOPGEN]) == tg, bar);
            __builtin_amdgcn_fence(__ATOMIC_ACQUIRE, "agent");
            xb_add(&bar[XB_XGEN(b.x)], 1u);
            asm volatile("s_waitcnt vmcnt(0)" ::: "memory");
        } else {
            XB_SPIN(xb_ld(&bar[XB_XGEN(b.x)]) == gen, bar);
            __builtin_amdgcn_fence(__ATOMIC_ACQUIRE, "agent");
            asm volatile("s_waitcnt vmcnt(0)" ::: "memory");
        }
    }
    __syncthreads();
}

struct Args { const float* in[23]; float* out; unsigned char* ws; int ph_lo, ph_hi; };
struct Frame {
    LAS unsigned char* lds;
    int tid, lane, wave, vcu, G;
    unsigned char* ws; float* out;
};
__device__ __forceinline__ void frame_refresh(Frame& F) { int t = threadIdx.x; asm volatile("" : "+v"(t)); F.tid = t; F.lane = t & 63; }

namespace pg8 {
constexpr int BM = 256, BK = 64, HALF = 128, HTB = HALF * BK * 2, STAGE_BYTES = 8 * HTB, NXCD = 8, WGM = 8;
__host__ __device__ __forceinline__ int lds_byte(int r, int c) { const int st = (r >> 4) * 2 + (c >> 5), rr = r & 15, cc = c & 31, ob = rr * 64 + cc * 2; return st * 1024 + (ob ^ (((ob >> 9) & 1) << 5)); }
__host__ __device__ __forceinline__ void stage_rc(int b, int& R, int& C) { const int st = b / 1024, sb = b % 1024, swz = sb ^ (((sb >> 9) & 1) << 5); R = (st >> 1) * 16 + swz / 64; C = (st & 1) * 32 + (swz % 64) / 2; }
__host__ __device__ __forceinline__ int perm32(int rho) { const int n = rho >> 4, i = rho & 15; return 8 * (i >> 2) + 4 * n + (i & 3); }

struct Unit { int pm, pn, e, mt; };

struct DenseOrder {
    static constexpr bool GATHER = false;
    int nM, nN, nwg, G, c, K;
    __device__ void init(int M, int N, int K_, int G_, int c_) { nM = M / BM; nN = N / BM; nwg = nM * nN; G = G_; c = c_; K = K_; }
    __device__ __forceinline__ bool next(int i, Unit& u) const {
        const long L = (long)i * G + c; if (L >= nwg) return false;
        int wgid = (int)L; { const int q = nwg / NXCD, r = nwg % NXCD, xcd = wgid % NXCD, off = wgid / NXCD; wgid = (xcd < r ? xcd * (q + 1) : r * (q + 1) + (xcd - r) * q) + off; }
        const int nig = WGM * nN, gid = wgid / nig, fm = gid * WGM, gsz = (nM - fm) < WGM ? (nM - fm) : WGM;
        u.pm = fm + ((wgid % nig) % gsz); u.pn = (wgid % nig) / gsz; u.e = 0; u.mt = 0; return true;
    }
    __device__ __forceinline__ size_t a_base(const Unit& u) const { return (size_t)u.pm * BM * K * 2; }
    __device__ __forceinline__ unsigned a_lane(const Unit&, int r) const { return (unsigned)r * (unsigned)K * 2u; }
    __device__ __forceinline__ size_t b_off(const Unit& u) const { return (size_t)u.pn * BM * K * 2; }
};

template <class Epi, class Sched>
__device__ __forceinline__ void gemm_phase(LAS unsigned char* lds, const bf16* Aptr, const bf16* Bptr, int K, const Sched& S, const Epi& E) {
    int tid_ = threadIdx.x; asm volatile("" : "+v"(tid_));
    const int tid = tid_, wid = __builtin_amdgcn_readfirstlane(tid >> 6), lane = tid & 63, wr = wid >> 2, wc = wid & 3, fr = lane & 15, fq = lane >> 4;
    const int nt = K / BK;
    int RA[2]; unsigned CA2[2], voffB[2];
#pragma unroll
    for (int i = 0; i < 2; ++i) { int R, C; stage_rc(tid * 16 + i * 8192, R, C); const int Rb = (R & ~31) + perm32(R & 31);
        RA[i] = R; CA2[i] = (unsigned)C * 2u; voffB[i] = (unsigned)(Rb * K + C) * 2u; }
    const size_t kstep = (size_t)(BK * 2);
    const size_t hstep = (size_t)HALF * K * 2;
    const unsigned ldsw = (unsigned)wid * 1024u;
    const int aoff = lds_byte(wr * 64 + fr, fq * 8), boff = lds_byte(wc * 32 + fr, fq * 8);
    const char* Abase = (const char*)Aptr;
#define PG8_SA(b, h) (((b) * 2 + (h)) * HTB)
#define PG8_SB(b, h) ((4 + (b) * 2 + (h)) * HTB)
#define PG8_STAGE(bufoff, gbase, voff) do { _Pragma("unroll") for (int _i = 0; _i < 2; ++_i) \
        __builtin_amdgcn_global_load_lds((const unsigned*)((const char*)(gbase) + (voff)[_i]), (LAS unsigned*)(lds + (bufoff) + ldsw + _i * 8192), 16, 0, 0); } while (0)
#define PG8_LDA(dst, b, h) do { _Pragma("unroll") for (int m = 0; m < 4; ++m) _Pragma("unroll") for (int k = 0; k < 2; ++k) dst[m][k] = *(const LAS bf16x8*)(lds + PG8_SA(b, h) + aoff + m * 2048 + k * 1024); } while (0)
#define PG8_LDB(dst, b, h) do { _Pragma("unroll") for (int n = 0; n < 2; ++n) _Pragma("unroll") for (int k = 0; k < 2; ++k) dst[n][k] = *(const LAS bf16x8*)(lds + PG8_SB(b, h) + boff + n * 2048 + k * 1024); } while (0)
#define PG8_MMA(ai, bj, At, Bt) do { __builtin_amdgcn_s_setprio(1); _Pragma("unroll") for (int m = 0; m < 4; ++m) _Pragma("unroll") for (int n = 0; n < 2; ++n) _Pragma("unroll") for (int k = 0; k < 2; ++k) \
        acc[ai][bj][m][n] = __builtin_amdgcn_mfma_f32_16x16x32_bf16(Bt[n][k], At[m][k], acc[ai][bj][m][n], 0, 0, 0); __builtin_amdgcn_s_setprio(0); } while (0)
#define PG8_WAIT_V(n) asm volatile("s_waitcnt vmcnt(" #n ")" ::: "memory")
#define PG8_WAIT_L(n) asm volatile("s_waitcnt lgkmcnt(" #n ")" ::: "memory")
#define PG8_BAR __builtin_amdgcn_s_barrier()
#define PG8_SCHED __builtin_amdgcn_sched_barrier(0)
    Unit cur, nxt; int ui = 0;
    if (!S.next(0, cur)) return;
    f32x4 acc[2][2][4][2];
#pragma unroll
    for (int a = 0; a < 2; ++a)
#pragma unroll
        for (int b = 0; b < 2; ++b)
#pragma unroll
            for (int m = 0; m < 4; ++m)
#pragma unroll
                for (int n = 0; n < 2; ++n) acc[a][b][m][n] = (f32x4){0.f, 0.f, 0.f, 0.f};
    bf16x8 At[4][2], B0[2][2], B1[2][2];
    unsigned vA0[2], vA1[2], nA0[2], nA1[2];
#pragma unroll
    for (int i = 0; i < 2; ++i) { vA0[i] = S.a_lane(cur, RA[i]) + CA2[i]; vA1[i] = S.a_lane(cur, HALF + RA[i]) + CA2[i]; }
    const char* cB = (const char*)Bptr + S.b_off(cur);
    const char* cA = Abase + S.a_base(cur);
    if (Sched::GATHER) VM_WAIT();
    PG8_STAGE(PG8_SB(0, 0), cB, voffB); PG8_STAGE(PG8_SB(0, 1), cB + hstep, voffB); PG8_STAGE(PG8_SA(0, 0), cA, vA0); PG8_STAGE(PG8_SA(0, 1), cA, vA1);
    if (wr == 1) PG8_BAR;
    PG8_WAIT_V(2); PG8_BAR;
    PG8_STAGE(PG8_SB(1, 0), cB + kstep, voffB); PG8_STAGE(PG8_SA(1, 0), cA + kstep, vA0); PG8_STAGE(PG8_SB(1, 1), cB + hstep + kstep, voffB);
    PG8_WAIT_V(6); PG8_BAR;
    for (;;) {
        const bool has_next = S.next(ui + 1, nxt);
        const char* nB = cB; const char* nA = cA;
        if (has_next) {
            int t2 = tid; if (Sched::GATHER) asm volatile("" : "+v"(t2));
#pragma unroll
            for (int i = 0; i < 2; ++i) { int R, C; stage_rc(t2 * 16 + i * 8192, R, C); nA0[i] = S.a_lane(nxt, R) + (unsigned)C * 2u; nA1[i] = S.a_lane(nxt, HALF + R) + (unsigned)C * 2u; }
            nB = (const char*)Bptr + S.b_off(nxt); nA = Abase + S.a_base(nxt);
            if (Sched::GATHER) VM_WAIT();
        } else {
#pragma unroll
            for (int i = 0; i < 2; ++i) { nA0[i] = vA0[i]; nA1[i] = vA1[i]; }
        }
        for (int t = 0; t < nt; t += 2) {
            const bool last = (t == nt - 2);
            const size_t k1 = (size_t)(t + 1) * kstep;
            const size_t k2 = (size_t)(t + 2) * kstep;
            unsigned w0[2], w1[2];
#pragma unroll
            for (int i = 0; i < 2; ++i) { w0[i] = last ? nA0[i] : vA0[i]; w1[i] = last ? nA1[i] : vA1[i]; }
            const char* b2 = last ? nB : cB + (size_t)(t + 2) * kstep; const char* b3 = b2 + kstep;
            const char* a1p = cA + k1; const char* a2p = last ? nA : cA + k2; const char* a3p = a2p + kstep;
            PG8_LDB(B0, 0, 0); PG8_LDB(B1, 0, 1); PG8_SCHED; PG8_LDA(At, 0, 0); PG8_STAGE(PG8_SA(1, 1), a1p, vA1);
            PG8_WAIT_V(8); PG8_WAIT_L(0); PG8_BAR; PG8_MMA(0, 0, At, B0); PG8_MMA(0, 1, At, B1); PG8_BAR; PG8_SCHED;
            PG8_LDA(At, 0, 1); PG8_STAGE(PG8_SB(0, 0), b2, voffB); PG8_STAGE(PG8_SB(0, 1), b2 + hstep, voffB); PG8_STAGE(PG8_SA(0, 0), a2p, w0);
            PG8_WAIT_V(8); PG8_WAIT_L(0); PG8_BAR; PG8_MMA(1, 0, At, B0); PG8_MMA(1, 1, At, B1); PG8_BAR; PG8_SCHED;
            PG8_LDB(B0, 1, 0); PG8_LDB(B1, 1, 1); PG8_SCHED; PG8_LDA(At, 1, 0); PG8_STAGE(PG8_SA(0, 1), a2p, w1);
            PG8_WAIT_V(8); PG8_WAIT_L(0); PG8_BAR; PG8_MMA(0, 0, At, B0); PG8_MMA(0, 1, At, B1); PG8_BAR; PG8_SCHED;
            PG8_LDA(At, 1, 1); PG8_STAGE(PG8_SB(1, 0), b3, voffB); PG8_STAGE(PG8_SB(1, 1), b3 + hstep, voffB); PG8_STAGE(PG8_SA(1, 0), a3p, w0);
            PG8_WAIT_V(8); PG8_WAIT_L(0); PG8_BAR; PG8_MMA(1, 0, At, B0); PG8_MMA(1, 1, At, B1); PG8_BAR; PG8_SCHED;
        }
        if (wr == 0) PG8_BAR;
        E(acc, cur, wr, wc, fr, fq);
        if (!has_next) break;
#pragma unroll
        for (int a = 0; a < 2; ++a)
#pragma unroll
            for (int b = 0; b < 2; ++b)
#pragma unroll
                for (int m = 0; m < 4; ++m)
#pragma unroll
                    for (int n = 0; n < 2; ++n) acc[a][b][m][n] = (f32x4){0.f, 0.f, 0.f, 0.f};
        cur = nxt; cB = nB; cA = nA; ++ui;
#pragma unroll
        for (int i = 0; i < 2; ++i) { vA0[i] = nA0[i]; vA1[i] = nA1[i]; }
        if (wr == 1) PG8_BAR;
    }
    PG8_WAIT_V(0);
    PG8_BAR;
#undef PG8_SA
#undef PG8_SB
#undef PG8_STAGE
#undef PG8_LDA
#undef PG8_LDB
#undef PG8_MMA
#undef PG8_WAIT_V
#undef PG8_WAIT_L
#undef PG8_BAR
#undef PG8_SCHED
}

template <class Epi, class Sched>
__device__ __forceinline__ void gemm_naive(const bf16* Aptr, const bf16* Bptr, int K, const Sched& S, const Epi& E) {
    Unit u;
    for (int i = 0; S.next(i, u); ++i) {
        const char* cB = (const char*)Bptr + S.b_off(u);
        for (int ch = threadIdx.x; ch < 256 * 32; ch += NTHR) {
            const int r = ch >> 5, c = (ch & 31) * 8;
            const bf16* a = (const bf16*)((const char*)Aptr + S.a_base(u) + S.a_lane(u, r));
            float s[8];
#pragma unroll
            for (int j = 0; j < 8; ++j) s[j] = 0.f;
            for (int k = 0; k < K; k += 8) {
                const u32x4 av = *(const u32x4*)(a + k);
                float af[8] = {bflo(av.x), bfhi(av.x), bflo(av.y), bfhi(av.y), bflo(av.z), bfhi(av.z), bflo(av.w), bfhi(av.w)};
#pragma unroll
                for (int j = 0; j < 8; ++j) {
                    const u32x4 bv = *(const u32x4*)((const bf16*)cB + (size_t)(c + j) * K + k);
                    s[j] += af[0] * bflo(bv.x) + af[1] * bfhi(bv.x) + af[2] * bflo(bv.y) + af[3] * bfhi(bv.y) + af[4] * bflo(bv.z) + af[5] * bfhi(bv.z) + af[6] * bflo(bv.w) + af[7] * bfhi(bv.w);
                }
            }
            E.chunk(u, r, c, (f32x4){s[0], s[1], s[2], s[3]}, (f32x4){s[4], s[5], s[6], s[7]});
        }
    }
}

template <class F> struct EpiWrap {
    F f;
    __device__ __forceinline__ void operator()(const f32x4 (&acc)[2][2][4][2], const Unit& u, int wr, int wc, int fr, int fq) const {
#pragma unroll
        for (int ai = 0; ai < 2; ++ai)
#pragma unroll
            for (int m = 0; m < 4; ++m) {
                const int r = ai * HALF + wr * 64 + m * 16 + fr;
#pragma unroll
                for (int bj = 0; bj < 2; ++bj) f.chunk(u, r, bj * HALF + wc * 32 + 8 * fq, acc[ai][bj][m][0], acc[ai][bj][m][1]);
            }
    }
    __device__ __forceinline__ void chunk(const Unit& u, int r, int c, f32x4 v0, f32x4 v1) const { f.chunk(u, r, c, v0, v1); }
};
}
using pg8::Unit;

template <class F, class Sched>
__device__ __forceinline__ void run_gemm(Frame& Fm, const bf16* A, const bf16* Bt, int K, const Sched& S, const F& f) {
    pg8::EpiWrap<F> E{f};
#if NAIVE_GEMM
    pg8::gemm_naive(A, Bt, K, S, E);
    VM_WAIT(); __syncthreads();
#else
    pg8::gemm_phase(Fm.lds, A, Bt, K, S, E);
#endif
}

__device__ __forceinline__ u32x4 pack8(f32x4 a, f32x4 b) { u32x4 w; w.x = pk2(a[0], a[1]); w.y = pk2(a[2], a[3]); w.z = pk2(b[0], b[1]); w.w = pk2(b[2], b[3]); return w; }
__device__ __forceinline__ void unpack8(u32x4 w, f32x4& a, f32x4& b) { a = (f32x4){bflo(w.x), bfhi(w.x), bflo(w.y), bfhi(w.y)}; b = (f32x4){bflo(w.z), bfhi(w.z), bflo(w.w), bfhi(w.w)}; }

struct EpiInProj {
    unsigned char* ws; bf16* ga; bf16* gd;
    __device__ __forceinline__ void chunk(const Unit& u, int r, int c, f32x4 v0, f32x4 v1) const {
        const int row = u.pm * 256 + r, col = u.pn * 256 + c;
        bf16* dst; float sc = 1.f; int act = 0;
        if (col < C_KA)      { dst = (bf16*)(ws + WS_QA) + (size_t)row * 512 + (col - C_QA); sc = 0.08838834764831845f; }
        else if (col < C_VA) { dst = (bf16*)(ws + WS_KA) + (size_t)row * 512 + (col - C_KA); }
        else if (col < C_RA) { dst = (bf16*)(ws + WS_VA) + (size_t)row * 1024 + (col - C_VA); }
        else if (col < C_QD) { dst = (bf16*)(ws + WS_RA) + (size_t)row * 1024 + (col - C_RA); act = 1; }
        else if (col < C_KD) { dst = (bf16*)(ws + WS_QD) + (size_t)row * 1536 + (col - C_QD); sc = 0.125f; }
        else if (col < C_VD) { dst = (bf16*)(ws + WS_KD) + (size_t)row * 1536 + (col - C_KD); }
        else if (col < C_GA) { dst = (bf16*)(ws + WS_VD) + (size_t)row * 1536 + (col - C_VD); }
        else if (col < C_GD) { dst = ga + (size_t)row * 1024 + (col - C_GA); act = 2; }
        else if (col < C_LR) { dst = gd + (size_t)row * 1024 + (col - C_GD); act = 2; }
        else {
            if (col < C_LR + 16) { float* l = (float*)(ws + WS_LR) + (size_t)row * 16 + (col - C_LR); *(f32x4*)l = v0; *(f32x4*)(l + 4) = v1; }
            return;
        }
        if (act == 1) {
#pragma unroll
            for (int j = 0; j < 4; ++j) { v0[j] = siluf_(v0[j]); v1[j] = siluf_(v1[j]); }
        } else if (act == 2) {
#pragma unroll
            for (int j = 0; j < 4; ++j) { v0[j] = sigmoidf_(v0[j]); v1[j] = sigmoidf_(v1[j]); }
        } else { v0 = v0 * sc; v1 = v1 * sc; }
        *(u32x4*)dst = pack8(v0, v1);
    }
};
struct EpiProjA {
    const bf16* gd; bf16* T;
    __device__ __forceinline__ void chunk(const Unit& u, int r, int c, f32x4 v0, f32x4 v1) const {
        const size_t o = (size_t)(u.pm * 256 + r) * 1024 + u.pn * 256 + c;
        f32x4 g0, g1; unpack8(*(const u32x4*)(gd + o), g0, g1);
        *(u32x4*)(T + o) = pack8(v0 * g0, v1 * g1);
    }
};
struct EpiProjG {
    const bf16* ga; const bf16* T; bf16* merged;
    __device__ __forceinline__ void chunk(const Unit& u, int r, int c, f32x4 v0, f32x4 v1) const {
        const size_t o = (size_t)(u.pm * 256 + r) * 1024 + u.pn * 256 + c;
        f32x4 g0, g1, t0, t1; unpack8(*(const u32x4*)(ga + o), g0, g1); unpack8(*(const u32x4*)(T + o), t0, t1);
        *(u32x4*)(merged + o) = pack8(v0 * g0 + t0, v1 * g1 + t1);
    }
};
struct EpiOut {
    const float* x; const float* mods; float* t1;
    __device__ __forceinline__ void chunk(const Unit& u, int r, int c, f32x4 v0, f32x4 v1) const {
        const int row = u.pm * 256 + r, col = u.pn * 256 + c, b = row >> 12;
        const size_t o = (size_t)row * 1024 + col;
        const float* g = mods + b * 6144 + 2 * 1024 + col;
        const f32x4 x0 = *(const f32x4*)(x + o), x1 = *(const f32x4*)(x + o + 4), g0 = *(const f32x4*)g, g1v = *(const f32x4*)(g + 4);
        *(f32x4*)(t1 + o) = x0 * ALPHA + g0 * v0; *(f32x4*)(t1 + o + 4) = x1 * ALPHA + g1v * v1;
    }
};
struct EpiMoeUp {
    bf16* H;
    __device__ __forceinline__ void chunk(const Unit& u, int r, int c, f32x4 v0, f32x4 v1) const {
        const size_t row = (size_t)u.pm * 256 + r; const int f = ((u.pn * 256 + c) >> 3) * 4;
        u32x2 w; w.x = pk2(siluf_(v0[0]) * v1[0], siluf_(v0[1]) * v1[1]); w.y = pk2(siluf_(v0[2]) * v1[2], siluf_(v0[3]) * v1[3]);
        *(u32x2*)(H + row * 512 + f) = w;
    }
};
struct EpiMoeDown {
    const unsigned* cnt; const unsigned* lst; const float* lstw; bf16* Y;
    __device__ __forceinline__ void chunk(const Unit& u, int r, int c, f32x4 v0, f32x4 v1) const {
        const unsigned pos = (unsigned)(u.mt * 256 + r);
        if (pos < cnt[u.e * CNT_STRIDE]) {
            const unsigned ent = lst[(size_t)u.e * NTOK + pos]; const float w = lstw[(size_t)u.e * NTOK + pos];
            bf16* dst = Y + ((size_t)(ent & 1u) * NTOK + (ent >> 1)) * 1024 + u.pn * 256 + c;
            *(u32x4*)dst = pack8(v0 * w, v1 * w);
        }
    }
};
struct MoeOrder {
    static constexpr bool GATHER = true;
    const LAS int* ts; const unsigned* cnt; const unsigned* lst; int G, c, mode;
    __device__ __forceinline__ bool next(int i, Unit& u) const {
        const int L = i * G + c, ntile = ts[32]; if (L >= 4 * ntile) return false;
        const int T = L >> 2; int e = 0;
        for (int j = 1; j < 32; ++j) e += (ts[j] <= T) ? 1 : 0;
        u.pm = T; u.pn = L & 3; u.e = e; u.mt = T - ts[e]; return true;
    }
    __device__ __forceinline__ size_t a_base(const Unit& u) const { return mode == 0 ? (size_t)0 : (size_t)u.pm * 256 * 1024; }
    __device__ __forceinline__ unsigned a_lane(const Unit& u, int r) const {
        if (mode == 0) { unsigned pos = (unsigned)(u.mt * 256 + r); if (pos >= cnt[u.e * CNT_STRIDE]) pos = 0; return (lst[(size_t)u.e * NTOK + pos] >> 1) * 2048u; }
        return (unsigned)r * 1024u;
    }
    __device__ __forceinline__ size_t b_off(const Unit& u) const {
        return mode == 0 ? ((size_t)u.e * 1024 + (size_t)u.pn * 256) * 1024 * 2 : ((size_t)u.e * 1024 + (size_t)u.pn * 256) * 512 * 2;
    }
};

struct MapWin { __device__ __forceinline__ int operator()(int n) const { return n < 3072 ? n : (n < 3088 ? C_LR + (n - 3072) : n - 16); } };
struct MapId { __device__ __forceinline__ int operator()(int n) const { return n; } };
struct MapGate { __device__ __forceinline__ int operator()(int f) const { return (f >> 2) * 8 + (f & 3); } };
struct MapUp { __device__ __forceinline__ int operator()(int f) const { return (f >> 2) * 8 + 4 + (f & 3); } };
template <class RowMap>
__device__ __forceinline__ void transpose_item(const float* W, int K, int N, bf16* WT, LAS float* scr, int item, int lane, RowMap rm) {
    const int nblk = (N + 31) / 32, kb = item / nblk, nb = item % nblk, k0 = 64 * kb, n0 = 32 * nb;
    const int kr = lane >> 3, nq = (lane & 7) * 4; const bool ok = (n0 + nq) < N;
    f32x4 v[8];
#pragma unroll
    for (int i = 0; i < 8; ++i) v[i] = ok ? *(const f32x4*)(W + (size_t)(k0 + 8 * i + kr) * N + n0 + nq) : (f32x4){0.f, 0.f, 0.f, 0.f};
#pragma unroll
    for (int i = 0; i < 8; ++i) { LAS float* d = scr + (8 * i + kr) * 33 + nq; d[0] = v[i][0]; d[1] = v[i][1]; d[2] = v[i][2]; d[3] = v[i][3]; }
    LDS_WAIT(); asm volatile("" ::: "memory");
    const int c = lane & 7;
#pragma unroll
    for (int j = 0; j < 4; ++j) { const int n = (lane >> 3) + 8 * j; const LAS float* s = scr + (8 * c) * 33 + n;
        u32x4 o; o.x = pk2(s[0 * 33], s[1 * 33]); o.y = pk2(s[2 * 33], s[3 * 33]); o.z = pk2(s[4 * 33], s[5 * 33]); o.w = pk2(s[6 * 33], s[7 * 33]);
        if (n0 + n < N) *(u32x4*)(WT + (size_t)rm(n0 + n) * K + k0 + 8 * c) = o; }
    LDS_WAIT(); asm volatile("" ::: "memory");
}
__device__ __forceinline__ int t5_bucket(int dist) {
    if (dist < 16) return dist;
    int large = 16 + (int)(log((double)dist / 16.0) / log(128.0) * 16.0);
    return large < 31 ? large : 31;
}
__device__ __forceinline__ void p0_phase(Frame& F, const Args& args) {
    LAS float* scr = (LAS float*)(F.lds + F.wave * 16384);
    LAS f32x4* sc = (LAS f32x4*)(F.lds + 131072);
    const float* c = args.in[1];
    for (int k = F.tid; k < 1024; k += NTHR) sc[k] = (f32x4){siluf_(c[k]), siluf_(c[1024 + k]), siluf_(c[2048 + k]), siluf_(c[3072 + k])};
    __syncthreads();
    const int gw = F.vcu * NWAVES + F.wave, NGW = F.G * NWAVES, lane = F.lane;
    float* mods = (float*)(F.ws + WS_MODS);
#pragma unroll 1
    for (int it = gw; it < 384; it += NGW) {
        const int col = it * 16 + (lane & 15), kq = lane >> 4; const float* w = args.in[3] + col;
        float a0 = 0.f, a1 = 0.f, a2 = 0.f, a3 = 0.f;
#pragma unroll 32
        for (int k = kq; k < 1024; k += 4) { const float wv = w[(size_t)k * 6144]; const f32x4 s = sc[k]; a0 += s.x * wv; a1 += s.y * wv; a2 += s.z * wv; a3 += s.w * wv; }
        a0 += __shfl_xor(a0, 16); a0 += __shfl_xor(a0, 32); a1 += __shfl_xor(a1, 16); a1 += __shfl_xor(a1, 32);
        a2 += __shfl_xor(a2, 16); a2 += __shfl_xor(a2, 32); a3 += __shfl_xor(a3, 16); a3 += __shfl_xor(a3, 32);
        if (lane < 16) { const float bb = args.in[4][col]; mods[col] = a0 + bb; mods[6144 + col] = a1 + bb; mods[2 * 6144 + col] = a2 + bb; mods[3 * 6144 + col] = a3 + bb; }
    }
    if (gw == NGW - 1) {
        float* bt = (float*)(F.ws + WS_BTAB);
        for (int i = lane; i < 24 * 129; i += 64) { const int h = i / 129, m = i % 129, dil = (h < 8) ? 1 : (h < 16 ? 4 : 16); bt[h * 132 + m] = args.in[2][t5_bucket(m * dil) * 24 + h]; }
    }
    constexpr int I_IN = 16 * 305, I_PG = 16 * 32, I_PA = 8 * 32, I_OUT = 16 * 32, I_PAD = 240;
    constexpr int NIT = I_IN + I_PG + I_PA + I_OUT + I_PAD;
#pragma unroll 1
    for (int it = gw; it < NIT; it += NGW) {
        int r = it;
        if (r < I_IN) { transpose_item(args.in[5], 1024, INCOLS, (bf16*)(F.ws + WS_WIN), scr, r, lane, MapWin()); continue; } r -= I_IN;
        if (r < I_PG) { transpose_item(args.in[9], 1024, 1024, (bf16*)(F.ws + WS_WPG), scr, r, lane, MapId()); continue; } r -= I_PG;
        if (r < I_PA) { transpose_item(args.in[10], 512, 1024, (bf16*)(F.ws + WS_WPA), scr, r, lane, MapId()); continue; } r -= I_PA;
        if (r < I_OUT) { transpose_item(args.in[11], 1024, 1024, (bf16*)(F.ws + WS_WOUT), scr, r, lane, MapId()); continue; } r -= I_OUT;
        { u32x4* z = (u32x4*)((bf16*)(F.ws + WS_WIN) + (size_t)(INCOLS + r) * 1024); z[lane] = (u32x4){0u, 0u, 0u, 0u}; z[64 + lane] = (u32x4){0u, 0u, 0u, 0u}; }
    }
}
__device__ __forceinline__ void convert_experts(Frame& F, const Args& args) {
    LAS float* scr = (LAS float*)(F.lds + F.wave * 16384);
    const int gw = F.vcu * NWAVES + F.wave, NGW = F.G * NWAVES, lane = F.lane;
    bf16* wgu = (bf16*)(F.ws + WS_WGU); bf16* wdn = (bf16*)(F.ws + WS_WDN);
#pragma unroll 1
    for (int it = gw; it < 3 * 8192; it += NGW) {
        const int kind = it >> 13, r = it & 8191, e = r >> 8, sub = r & 255;
        if (kind == 0) transpose_item(args.in[18] + (size_t)e * 1024 * 512, 1024, 512, wgu + (size_t)e * 1024 * 1024, scr, sub, lane, MapGate());
        else if (kind == 1) transpose_item(args.in[19] + (size_t)e * 1024 * 512, 1024, 512, wgu + (size_t)e * 1024 * 1024, scr, sub, lane, MapUp());
        else transpose_item(args.in[20] + (size_t)e * 512 * 1024, 512, 1024, wdn + (size_t)e * 1024 * 512, scr, sub, lane, MapId());
    }
}
__device__ __forceinline__ void p0b_phase(Frame& F, const Args& args) {
    const int gw = F.vcu * NWAVES + F.wave, NGW = F.G * NWAVES, lane = F.lane;
    const float* mods = (const float*)(F.ws + WS_MODS); bf16* U = (bf16*)(F.ws + WS_U);
#pragma unroll 1
    for (int m = gw; m < NTOK; m += NGW) {
        const int b = m >> 12; const f32x4* xr = (const f32x4*)(args.in[0] + (size_t)m * 1024) + lane;
        const f32x4* sh = (const f32x4*)(mods + b * 6144) + lane; const f32x4* sc = (const f32x4*)(mods + b * 6144 + 1024) + lane;
        u32x2* o = (u32x2*)(U + (size_t)m * 1024) + lane;
#pragma unroll
        for (int j = 0; j < 4; ++j) { const f32x4 v = xr[64 * j] * (sc[64 * j] + 1.f) + sh[64 * j]; u32x2 w; w.x = pk2(v[0], v[1]); w.y = pk2(v[2], v[3]); o[64 * j] = w; }
    }
}

__device__ __forceinline__ s16x4 tr_read(const LAS unsigned char* p) {
    typedef short v4i16_t __attribute__((ext_vector_type(4)));
    return __builtin_bit_cast(s16x4, __builtin_amdgcn_ds_read_tr16_b64_v4i16((LAS v4i16_t*)p));
}
__device__ __forceinline__ void attn_phase(Frame& F) {
    const int tid = F.tid, lane = F.lane, wid = F.wave, half = wid >> 2, w4 = wid & 3, l31 = lane & 31, hi = lane >> 5;
    LAS unsigned char* Kl = F.lds + half * 36864;
    LAS unsigned char* Vl = F.lds + 73728 + half * 36864;
    LAS float* bl = (LAS float*)(F.lds + 147456) + half * 192;
    bf16* QD = (bf16*)(F.ws + WS_QD); const bf16* KD = (const bf16*)(F.ws + WS_KD); const bf16* VD = (const bf16*)(F.ws + WS_VD);
    float* LSE = (float*)(F.ws + WS_LSE); const float* BT = (const float*)(F.ws + WS_BTAB);
#pragma unroll 1
    for (int it = 0;; ++it) {
        const int L = it * F.G + F.vcu; if (L >= 1536) break;
        const int g = L >> 9, wq = L & 511, b = wq >> 7, w2 = wq & 127, hp = w2 >> 5, w3 = w2 & 31;
        const int dsh = 2 * g, dil = 1 << dsh, nblk = 32 >> dsh, r = w3 / nblk, nb = w3 % nblk;
        const int head = 2 * hp + half, colb = g * 512 + head * 64;
        __syncthreads();
        {
            const int t = tid & 255, ch = t & 7;
#pragma unroll
            for (int p = 0; p < 8; ++p) {
                const int row = p * 32 + (t >> 3), lidx = nb * 128 - 128 + row;
                u32x4 kv = (u32x4){0u, 0u, 0u, 0u}, vv = kv;
                if (lidx >= 0) { const size_t o = (size_t)(b * SEQ + lidx * dil + r) * 1536 + colb + ch * 8; kv = *(const u32x4*)(KD + o); vv = *(const u32x4*)(VD + o); }
                *(LAS u32x4*)(Kl + row * 144 + ch * 16) = kv; *(LAS u32x4*)(Vl + row * 144 + ch * 16) = vv;
            }
            if (t < 192) bl[t] = (t >= 32 && t <= 160) ? BT[(g * 8 + head) * 132 + t - 32] : 0.f;
        }
        const int qi = 32 * w4 + l31; const size_t qtok = (size_t)(b * SEQ + (nb * 128 + qi) * dil + r);
        bf16x8 qf[4];
#pragma unroll
        for (int kk = 0; kk < 4; ++kk) qf[kk] = *(const bf16x8*)(QD + qtok * 1536 + colb + kk * 16 + hi * 8);
        __syncthreads();
        f32x16 sa[5]; float mx = -INFINITY;
        const int mb = l31 + 128 - 4 * hi;
        const LAS float* blq = bl + (mb - 123);
        const unsigned mlim = (nb > 0) ? 128u : (unsigned)(qi < 128 ? qi : 128);
#pragma unroll
        for (int t = 0; t < 5; ++t) {
            const int kt = w4 + t; const bool act = (nb > 0) || (kt >= 4);
            f32x16 a = {0.f, 0.f, 0.f, 0.f, 0.f, 0.f, 0.f, 0.f, 0.f, 0.f, 0.f, 0.f, 0.f, 0.f, 0.f, 0.f};
            if (act) {
                const LAS unsigned char* kp = Kl + (32 * kt + l31) * 144 + hi * 16;
#pragma unroll
                for (int kk = 0; kk < 4; ++kk) { const bf16x8 kf = *(const LAS bf16x8*)(kp + kk * 32); a = __builtin_amdgcn_mfma_f32_32x32x16_bf16(kf, qf[kk], a, 0, 0, 0); }
            }
#pragma unroll
            for (int rr = 0; rr < 16; ++rr) {
                const int cc = 32 * t + (rr & 3) + 8 * (rr >> 2);
                const unsigned m = (unsigned)(mb - cc);
                float s = a[rr] + blq[155 - cc];
                s = (m <= mlim) ? s : -INFINITY;
                a[rr] = s; mx = fmaxf(mx, s);
            }
            sa[t] = a;
        }
        mx = fmaxf(mx, __shfl_xor(mx, 32));
        float sum = 0.f;
#pragma unroll
        for (int t = 0; t < 5; ++t)
#pragma unroll
            for (int rr = 0; rr < 16; ++rr) { const float p = __expf(sa[t][rr] - mx); sa[t][rr] = p; sum += p; }
        sum += __shfl_xor(sum, 32);
        f32x16 o0 = {0.f, 0.f, 0.f, 0.f, 0.f, 0.f, 0.f, 0.f, 0.f, 0.f, 0.f, 0.f, 0.f, 0.f, 0.f, 0.f}, o1 = o0;
        const int i16 = lane & 15, g2 = (lane >> 4) & 1;
        const LAS unsigned char* vbase = Vl + (4 * hi + (i16 >> 2)) * 144 + (16 * g2 + 4 * (i16 & 3)) * 2;
#pragma unroll
        for (int t = 0; t < 5; ++t) {
            const int kt = w4 + t; const bool act = (nb > 0) || (kt >= 4);
            if (act) {
#pragma unroll
                for (int s2 = 0; s2 < 2; ++s2) {
                    u32x4 pw; pw.x = pk2(sa[t][8 * s2 + 0], sa[t][8 * s2 + 1]); pw.y = pk2(sa[t][8 * s2 + 2], sa[t][8 * s2 + 3]); pw.z = pk2(sa[t][8 * s2 + 4], sa[t][8 * s2 + 5]); pw.w = pk2(sa[t][8 * s2 + 6], sa[t][8 * s2 + 7]);
                    const bf16x8 pf = __builtin_bit_cast(bf16x8, pw);
                    const LAS unsigned char* vp = vbase + (32 * kt + 16 * s2) * 144;
                    const s16x4 a0 = tr_read(vp), a1 = tr_read(vp + 8 * 144), c0 = tr_read(vp + 64), c1 = tr_read(vp + 8 * 144 + 64);
                    const bf16x8 vf0 = (bf16x8){a0[0], a0[1], a0[2], a0[3], a1[0], a1[1], a1[2], a1[3]};
                    const bf16x8 vf1 = (bf16x8){c0[0], c0[1], c0[2], c0[3], c1[0], c1[1], c1[2], c1[3]};
                    o0 = __builtin_amdgcn_mfma_f32_32x32x16_bf16(vf0, pf, o0, 0, 0, 0);
                    o1 = __builtin_amdgcn_mfma_f32_32x32x16_bf16(vf1, pf, o1, 0, 0, 0);
                }
            }
        }
        const float inv = 1.f / sum;
        bf16* orow = QD + qtok * 1536 + colb;
#pragma unroll
        for (int a4 = 0; a4 < 4; ++a4) {
            u32x2 w0, w1;
            w0.x = pk2(o0[4 * a4] * inv, o0[4 * a4 + 1] * inv); w0.y = pk2(o0[4 * a4 + 2] * inv, o0[4 * a4 + 3] * inv);
            w1.x = pk2(o1[4 * a4] * inv, o1[4 * a4 + 1] * inv); w1.y = pk2(o1[4 * a4 + 2] * inv, o1[4 * a4 + 3] * inv);
            *(u32x2*)(orow + 8 * a4 + 4 * hi) = w0; *(u32x2*)(orow + 32 + 8 * a4 + 4 * hi) = w1;
        }
        if (hi == 0) LSE[qtok * 24 + g * 8 + head] = mx + __logf(sum);
    }
    __syncthreads();
}
__device__ __forceinline__ void combine_phase(Frame& F) {
    const int gw = F.vcu * NWAVES + F.wave, NGW = F.G * NWAVES, lane = F.lane, hh = lane >> 3, ch = lane & 7;
    const bf16* OG = (const bf16*)(F.ws + WS_QD); const float* LSE = (const float*)(F.ws + WS_LSE); bf16* YA = (bf16*)(F.ws + WS_YATT);
#pragma unroll 1
    for (int m = gw; m < NTOK; m += NGW) {
        const float l0 = LSE[(size_t)m * 24 + hh], l1 = LSE[(size_t)m * 24 + 8 + hh], l2 = LSE[(size_t)m * 24 + 16 + hh];
        const float mm = fmaxf(l0, fmaxf(l1, l2)); float e0 = __expf(l0 - mm), e1 = __expf(l1 - mm), e2 = __expf(l2 - mm); const float is = 1.f / (e0 + e1 + e2);
        e0 *= is; e1 *= is; e2 *= is;
        const bf16* o = OG + (size_t)m * 1536 + hh * 64 + ch * 8;
        f32x4 a0, a1, b0, b1, c0, c1; unpack8(*(const u32x4*)o, a0, a1); unpack8(*(const u32x4*)(o + 512), b0, b1); unpack8(*(const u32x4*)(o + 1024), c0, c1);
        *(u32x4*)(YA + (size_t)m * 512 + hh * 64 + ch * 8) = pack8(a0 * e0 + b0 * e1 + c0 * e2, a1 * e0 + b1 * e1 + c1 * e2);
    }
}

constexpr int GA_LB = 0, GA_QT = 33792, GA_KT = 51200, GA_KH = 68608, GA_VT = 87040, GA_AT = 123904, GA_LR = 133120, GA_WG = 137216, GA_BG = 145408, GA_QS = 145920;
__device__ __forceinline__ float log_sigmoid_(float x) { return fminf(x, 0.f) - log1pf(__expf(-fabsf(x))); }
__device__ __forceinline__ void gla_a_phase(Frame& F, const Args& args) {
    const int tid = F.tid, lane = F.lane, wid = F.wave, l31 = lane & 31, hi = lane >> 5;
    LAS unsigned char* lds = F.lds;
    LAS float* LB = (LAS float*)(lds + GA_LB); LAS float* LRs = (LAS float*)(lds + GA_LR); LAS float* WG = (LAS float*)(lds + GA_WG); LAS float* BG = (LAS float*)(lds + GA_BG); LAS float* QS = (LAS float*)(lds + GA_QS);
    bf16* QA = (bf16*)(F.ws + WS_QA); const bf16* KA = (const bf16*)(F.ws + WS_KA); bf16* VA = (bf16*)(F.ws + WS_VA);
    const float* LR = (const float*)(F.ws + WS_LR); bf16* DS = (bf16*)(F.ws + WS_DS); float* DEC = (float*)(F.ws + WS_DECAY);
#pragma unroll 1
    for (int it = 0;; ++it) {
        const int U = it * F.G + F.vcu; if (U >= 1024) break;
        const int bh = U >> 6, c = U & 63, b = bh >> 2, h = bh & 3; const size_t tok0 = (size_t)b * SEQ + c * 64;
        __syncthreads();
        if (tid < 256) *(LAS f32x4*)(LRs + tid * 4) = *(const f32x4*)(LR + tok0 * 16 + tid * 4);
        for (int i = tid; i < 2048; i += NTHR) WG[i] = args.in[6][(i >> 7) * 512 + h * 128 + (i & 127)];
        if (tid < 128) BG[tid] = args.in[7][h * 128 + tid];
        __syncthreads();
        {
            const int k = tid & 127, tq = tid >> 7; float wg[16];
#pragma unroll
            for (int j = 0; j < 16; ++j) wg[j] = WG[j * 128 + k];
            const float bg = BG[k]; float cs = 0.f;
#pragma unroll 4
            for (int tt = 0; tt < 16; ++tt) { const int t = tq * 16 + tt; float lg = bg;
#pragma unroll
                for (int j4 = 0; j4 < 4; ++j4) { const f32x4 l4 = *(const LAS f32x4*)(LRs + t * 16 + j4 * 4); lg += l4[0] * wg[4 * j4] + l4[1] * wg[4 * j4 + 1] + l4[2] * wg[4 * j4 + 2] + l4[3] * wg[4 * j4 + 3]; }
                cs += log_sigmoid_(lg) * (1.f / 16.f); LB[t * 132 + k] = cs; }
            QS[tq * 128 + k] = cs;
            __syncthreads();
            float off = 0.f;
#pragma unroll
            for (int q = 0; q < 3; ++q) off += (q < tq) ? QS[q * 128 + k] : 0.f;
            if (tq > 0) {
#pragma unroll 4
                for (int tt = 0; tt < 16; ++tt) LB[(tq * 16 + tt) * 132 + k] += off;
            }
        }
        __syncthreads();
        {
            const int t = lane; const size_t tok = tok0 + t;
#pragma unroll
            for (int p = 0; p < 2; ++p) {
                const int kc = wid * 2 + p;
                f32x4 q0, q1, k0, k1; unpack8(*(const u32x4*)(QA + tok * 512 + h * 128 + kc * 8), q0, q1); unpack8(*(const u32x4*)(KA + tok * 512 + h * 128 + kc * 8), k0, k1);
                const f32x4 b0 = *(const LAS f32x4*)(LB + t * 132 + kc * 8), b1 = *(const LAS f32x4*)(LB + t * 132 + kc * 8 + 4);
                const f32x4 e0 = *(const LAS f32x4*)(LB + 63 * 132 + kc * 8), e1 = *(const LAS f32x4*)(LB + 63 * 132 + kc * 8 + 4);
                f32x4 qt0, qt1, kt0, kt1, kh0, kh1;
#pragma unroll
                for (int j = 0; j < 4; ++j) {
                    qt0[j] = q0[j] * __expf(b0[j]); qt1[j] = q1[j] * __expf(b1[j]);
                    kt0[j] = k0[j] * __expf(-b0[j]); kt1[j] = k1[j] * __expf(-b1[j]);
                    kh0[j] = k0[j] * __expf(e0[j] - b0[j]); kh1[j] = k1[j] * __expf(e1[j] - b1[j]);
                }
                const u32x4 qw = pack8(qt0, qt1);
                *(LAS u32x4*)(lds + GA_QT + t * 272 + kc * 16) = qw; *(u32x4*)(QA + tok * 512 + h * 128 + kc * 8) = qw;
                *(LAS u32x4*)(lds + GA_KT + t * 272 + kc * 16) = pack8(kt0, kt1);
#pragma unroll
                for (int j = 0; j < 4; ++j) { *(LAS bf16*)(lds + GA_KH + (kc * 8 + j) * 144 + t * 2) = f2bf(kh0[j]); *(LAS bf16*)(lds + GA_KH + (kc * 8 + 4 + j) * 144 + t * 2) = f2bf(kh1[j]); }
            }
#pragma unroll
            for (int p = 0; p < 4; ++p) {
                const int vc = wid * 4 + p; const u32x4 vv = *(const u32x4*)(VA + tok * 1024 + h * 256 + vc * 8);
                const unsigned w[4] = {vv.x, vv.y, vv.z, vv.w};
#pragma unroll
                for (int j = 0; j < 4; ++j) { *(LAS bf16*)(lds + GA_VT + (vc * 8 + 2 * j) * 144 + t * 2) = (bf16)(w[j] & 0xffffu); *(LAS bf16*)(lds + GA_VT + (vc * 8 + 2 * j + 1) * 144 + t * 2) = (bf16)(w[j] >> 16); }
            }
            if (tid < 128) DEC[(size_t)U * 128 + tid] = __expf(LB[63 * 132 + tid]);
        }
        __syncthreads();
        if (wid < 4) {
            const int mt = wid >> 1, nt = wid & 1;
            f32x16 a = {0.f, 0.f, 0.f, 0.f, 0.f, 0.f, 0.f, 0.f, 0.f, 0.f, 0.f, 0.f, 0.f, 0.f, 0.f, 0.f};
#pragma unroll
            for (int kk = 0; kk < 8; ++kk) {
                const bf16x8 qf = *(const LAS bf16x8*)(lds + GA_QT + (32 * mt + l31) * 272 + kk * 32 + hi * 16);
                const bf16x8 kf = *(const LAS bf16x8*)(lds + GA_KT + (32 * nt + l31) * 272 + kk * 32 + hi * 16);
                a = __builtin_amdgcn_mfma_f32_32x32x16_bf16(qf, kf, a, 0, 0, 0);
            }
            const int s = 32 * nt + l31;
#pragma unroll
            for (int rr = 0; rr < 16; ++rr) { const int t = 32 * mt + crow(rr, hi); *(LAS bf16*)(lds + GA_AT + t * 144 + s * 2) = f2bf(t >= s ? a[rr] : 0.f); }
        }
        __syncthreads();
        {
            f32x16 a0 = {0.f, 0.f, 0.f, 0.f, 0.f, 0.f, 0.f, 0.f, 0.f, 0.f, 0.f, 0.f, 0.f, 0.f, 0.f, 0.f}, a1 = a0;
#pragma unroll
            for (int ks = 0; ks < 4; ++ks) {
                const bf16x8 vf = *(const LAS bf16x8*)(lds + GA_VT + (32 * wid + l31) * 144 + ks * 32 + hi * 16);
                const bf16x8 t0 = *(const LAS bf16x8*)(lds + GA_AT + l31 * 144 + ks * 32 + hi * 16);
                const bf16x8 t1 = *(const LAS bf16x8*)(lds + GA_AT + (32 + l31) * 144 + ks * 32 + hi * 16);
                a0 = __builtin_amdgcn_mfma_f32_32x32x16_bf16(vf, t0, a0, 0, 0, 0);
                a1 = __builtin_amdgcn_mfma_f32_32x32x16_bf16(vf, t1, a1, 0, 0, 0);
            }
            bf16* o0 = VA + (tok0 + l31) * 1024 + h * 256 + 32 * wid + 4 * hi; bf16* o1 = o0 + 32 * 1024;
#pragma unroll
            for (int a4 = 0; a4 < 4; ++a4) {
                u32x2 w0, w1; w0.x = pk2(a0[4 * a4], a0[4 * a4 + 1]); w0.y = pk2(a0[4 * a4 + 2], a0[4 * a4 + 3]); w1.x = pk2(a1[4 * a4], a1[4 * a4 + 1]); w1.y = pk2(a1[4 * a4 + 2], a1[4 * a4 + 3]);
                *(u32x2*)(o0 + 8 * a4) = w0; *(u32x2*)(o1 + 8 * a4) = w1;
            }
        }
        {
            f32x16 a[4];
#pragma unroll
            for (int mt = 0; mt < 4; ++mt) a[mt] = (f32x16){0.f, 0.f, 0.f, 0.f, 0.f, 0.f, 0.f, 0.f, 0.f, 0.f, 0.f, 0.f, 0.f, 0.f, 0.f, 0.f};
#pragma unroll
            for (int ks = 0; ks < 4; ++ks) {
                const bf16x8 vf = *(const LAS bf16x8*)(lds + GA_VT + (32 * wid + l31) * 144 + ks * 32 + hi * 16);
#pragma unroll
                for (int mt = 0; mt < 4; ++mt) { const bf16x8 kf = *(const LAS bf16x8*)(lds + GA_KH + (32 * mt + l31) * 144 + ks * 32 + hi * 16); a[mt] = __builtin_amdgcn_mfma_f32_32x32x16_bf16(kf, vf, a[mt], 0, 0, 0); }
            }
            bf16* d = DS + (size_t)U * 32768 + (size_t)(32 * wid + l31) * 128 + 4 * hi;
#pragma unroll
            for (int mt = 0; mt < 4; ++mt)
#pragma unroll
                for (int a4 = 0; a4 < 4; ++a4) { u32x2 w; w.x = pk2(a[mt][4 * a4], a[mt][4 * a4 + 1]); w.y = pk2(a[mt][4 * a4 + 2], a[mt][4 * a4 + 3]); *(u32x2*)(d + 32 * mt + 8 * a4) = w; }
        }
    }
    __syncthreads();
}
__device__ __forceinline__ void gla_scan_phase(Frame& F) {
    bf16* DS = (bf16*)(F.ws + WS_DS); const float* DEC = (const float*)(F.ws + WS_DECAY);
#pragma unroll 1
    for (int e4 = F.vcu * NTHR + F.tid; e4 < 16 * 8192; e4 += F.G * NTHR) {
        const int bh = e4 >> 13, rem = e4 & 8191; const size_t eo = (size_t)(rem >> 5) * 128 + (rem & 31) * 4;
        f32x4 s = {0.f, 0.f, 0.f, 0.f};
#pragma unroll 8
        for (int c = 0; c < 64; ++c) {
            const size_t U = (size_t)bh * 64 + c; u32x2* p = (u32x2*)(DS + U * 32768 + eo);
            const u32x2 w = *p; const f32x4 dc = *(const f32x4*)(DEC + U * 128 + (rem & 31) * 4);
            u32x2 o; o.x = pk2(s[0], s[1]); o.y = pk2(s[2], s[3]); *p = o;
            s[0] = s[0] * dc[0] + bflo(w.x); s[1] = s[1] * dc[1] + bfhi(w.x); s[2] = s[2] * dc[2] + bflo(w.y); s[3] = s[3] * dc[3] + bfhi(w.y);
        }
    }
}
__device__ __forceinline__ void gla_c_phase(Frame& F, const Args& args) {
    const int tid = F.tid, lane = F.lane, wid = F.wave, l31 = lane & 31, hi = lane >> 5;
    LAS unsigned char* lds = F.lds; LAS float* SS = (LAS float*)(lds + 20480);
    const bf16* QA = (const bf16*)(F.ws + WS_QA); const bf16* OI = (const bf16*)(F.ws + WS_VA); const bf16* RA = (const bf16*)(F.ws + WS_RA);
    const bf16* DS = (const bf16*)(F.ws + WS_DS); bf16* YG = (bf16*)(F.ws + WS_YGLA);
#pragma unroll 1
    for (int it = 0;; ++it) {
        const int U = it * F.G + F.vcu; if (U >= 1024) break;
        const int bh = U >> 6, c = U & 63, b = bh >> 2, h = bh & 3; const size_t tok0 = (size_t)b * SEQ + c * 64;
        __syncthreads();
#pragma unroll
        for (int p = 0; p < 2; ++p) { const int ch = tid + p * NTHR, t = ch >> 4, kc = ch & 15; *(LAS u32x4*)(lds + t * 272 + kc * 16) = *(const u32x4*)(QA + (tok0 + t) * 512 + h * 128 + kc * 8); }
        __syncthreads();
        f32x16 a0 = {0.f, 0.f, 0.f, 0.f, 0.f, 0.f, 0.f, 0.f, 0.f, 0.f, 0.f, 0.f, 0.f, 0.f, 0.f, 0.f}, a1 = a0;
        const bf16* srow = DS + (size_t)U * 32768 + (size_t)(32 * wid + l31) * 128 + hi * 8;
#pragma unroll
        for (int kk = 0; kk < 8; ++kk) {
            const bf16x8 sf = *(const bf16x8*)(srow + kk * 16);
            const bf16x8 q0 = *(const LAS bf16x8*)(lds + l31 * 272 + kk * 32 + hi * 16);
            const bf16x8 q1 = *(const LAS bf16x8*)(lds + (32 + l31) * 272 + kk * 32 + hi * 16);
            a0 = __builtin_amdgcn_mfma_f32_32x32x16_bf16(sf, q0, a0, 0, 0, 0);
            a1 = __builtin_amdgcn_mfma_f32_32x32x16_bf16(sf, q1, a1, 0, 0, 0);
        }
        const size_t e0 = (tok0 + l31) * 1024 + h * 256 + 32 * wid + 4 * hi, e1 = e0 + 32 * 1024;
        float q0s = 0.f, q1s = 0.f;
#pragma unroll
        for (int a4 = 0; a4 < 4; ++a4) {
            const u32x2 w0 = *(const u32x2*)(OI + e0 + 8 * a4), w1 = *(const u32x2*)(OI + e1 + 8 * a4);
            a0[4 * a4] += bflo(w0.x); a0[4 * a4 + 1] += bfhi(w0.x); a0[4 * a4 + 2] += bflo(w0.y); a0[4 * a4 + 3] += bfhi(w0.y);
            a1[4 * a4] += bflo(w1.x); a1[4 * a4 + 1] += bfhi(w1.x); a1[4 * a4 + 2] += bflo(w1.y); a1[4 * a4 + 3] += bfhi(w1.y);
#pragma unroll
            for (int j = 0; j < 4; ++j) { q0s += a0[4 * a4 + j] * a0[4 * a4 + j]; q1s += a1[4 * a4 + j] * a1[4 * a4 + j]; }
        }
        q0s += __shfl_xor(q0s, 32); q1s += __shfl_xor(q1s, 32);
        if (hi == 0) { SS[wid * 64 + l31] = q0s; SS[wid * 64 + 32 + l31] = q1s; }
        __syncthreads();
        float t0 = 0.f, t1 = 0.f;
#pragma unroll
        for (int w = 0; w < 8; ++w) { t0 += SS[w * 64 + l31]; t1 += SS[w * 64 + 32 + l31]; }
        const float r0 = rsqrtf(t0 * (1.f / 256.f) + LN_EPS), r1 = rsqrtf(t1 * (1.f / 256.f) + LN_EPS);
        const float* ng = args.in[8] + h * 256 + 32 * wid + 4 * hi;
#pragma unroll
        for (int a4 = 0; a4 < 4; ++a4) {
            const f32x4 g4 = *(const f32x4*)(ng + 8 * a4);
            const u32x2 s0 = *(const u32x2*)(RA + e0 + 8 * a4), s1 = *(const u32x2*)(RA + e1 + 8 * a4);
            u32x2 w0, w1;
            w0.x = pk2(a0[4 * a4] * r0 * g4[0] * bflo(s0.x), a0[4 * a4 + 1] * r0 * g4[1] * bfhi(s0.x)); w0.y = pk2(a0[4 * a4 + 2] * r0 * g4[2] * bflo(s0.y), a0[4 * a4 + 3] * r0 * g4[3] * bfhi(s0.y));
            w1.x = pk2(a1[4 * a4] * r1 * g4[0] * bflo(s1.x), a1[4 * a4 + 1] * r1 * g4[1] * bfhi(s1.x)); w1.y = pk2(a1[4 * a4 + 2] * r1 * g4[2] * bflo(s1.y), a1[4 * a4 + 3] * r1 * g4[3] * bfhi(s1.y));
            *(u32x2*)(YG + e0 + 8 * a4) = w0; *(u32x2*)(YG + e1 + 8 * a4) = w1;
        }
    }
    __syncthreads();
}

__device__ __forceinline__ void ln1_router_phase(Frame& F, const Args& args) {
    const int tid = F.tid, lane = F.lane;
    LAS float* WR = (LAS float*)F.lds;
    LAS float* LG = (LAS float*)(F.lds + 147456); LAS float* LBi = LG + 1024;
    {
        f32x4 ve[16], vg[2]; const f32x4* we = (const f32x4*)args.in[16]; const f32x4* wg4 = (const f32x4*)args.in[14];
#pragma unroll
        for (int j = 0; j < 16; ++j) ve[j] = we[tid + NTHR * j];
#pragma unroll
        for (int j = 0; j < 2; ++j) vg[j] = wg4[tid + NTHR * j];
        const float g0 = args.in[12][tid], g1 = args.in[12][tid + NTHR], b0 = args.in[13][tid], b1 = args.in[13][tid + NTHR];
#pragma unroll
        for (int j = 0; j < 16; ++j) { const int idx = tid + NTHR * j, k = idx >> 3, c4 = idx & 7; *(LAS f32x4*)(WR + k * 36 + 4 + 4 * c4) = ve[j]; }
#pragma unroll
        for (int j = 0; j < 2; ++j) *(LAS f32x4*)(WR + (tid + NTHR * j) * 36) = vg[j];
        LG[tid] = g0; LG[tid + NTHR] = g1; LBi[tid] = b0; LBi[tid + NTHR] = b1;
    }
    __syncthreads();
    const int gw = F.vcu * NWAVES + F.wave, NGW = F.G * NWAVES;
    float* X1 = F.out; const float* mods = (const float*)(F.ws + WS_MODS); bf16* U2 = (bf16*)(F.ws + WS_U2);
    unsigned* cnt = (unsigned*)(F.ws + WS_CTL) + CW_CNT; unsigned* lst = (unsigned*)(F.ws + WS_LST); float* lstw = (float*)(F.ws + WS_LSTW);
    LAS unsigned* lcnt = (LAS unsigned*)(F.lds + 155648); LAS unsigned* lbase = lcnt + 32; LAS unsigned* rec = lcnt + 64;
    if (tid < 32) lcnt[tid] = 0u;
    if (tid < 64) rec[tid * 4 + 1] = 0xffffffffu;
    __syncthreads();
    int ti = 0;
#pragma unroll 1
    for (int m = gw; m < NTOK; m += NGW, ++ti) {
        const int b = m >> 12; float* xr = X1 + (size_t)m * 1024;
        unsigned lane_ = (unsigned)lane; asm volatile("" : "+v"(lane_));
        const float* sc2 = mods + b * 6144 + 4 * 1024 + lane_; const float* sh2 = mods + b * 6144 + 3 * 1024 + lane_;
        float x[16], sc[16], sh[16]; float s = 0.f;
#pragma unroll
        for (int i = 0; i < 16; ++i) { x[i] = xr[lane_ + 64 * i]; sc[i] = sc2[64 * i]; sh[i] = sh2[64 * i]; }
#pragma unroll
        for (int i = 0; i < 16; ++i) s += x[i];
        const float mean = wave_sum(s) * (1.f / 1024.f); float s2 = 0.f;
#pragma unroll
        for (int i = 0; i < 16; ++i) { x[i] -= mean; s2 += x[i] * x[i]; }
        const float rstd = rsqrtf(wave_sum(s2) * (1.f / 1024.f) + LN_EPS);
        float acc[36];
#pragma unroll
        for (int c = 0; c < 36; ++c) acc[c] = 0.f;
        asm volatile("" ::: "memory");
#pragma unroll
        for (int i = 0; i < 16; ++i) {
            const unsigned col = lane_ + 64u * i;
            const float x1 = x[i] * rstd * LG[col] + LBi[col];
            xr[col] = x1;
            const float u2 = x1 * (1.f + sc[i]) + sh[i];
            U2[(size_t)m * 1024 + col] = f2bf(u2);
#pragma unroll
            for (int c4 = 0; c4 < 9; ++c4) { const f32x4 w = *(const LAS f32x4*)(WR + col * 36 + c4 * 4); acc[4 * c4] += u2 * w[0]; acc[4 * c4 + 1] += u2 * w[1]; acc[4 * c4 + 2] += u2 * w[2]; acc[4 * c4 + 3] += u2 * w[3]; }
            if ((i & 1) == 1) asm volatile("" : "+v"(acc[0]), "+v"(acc[9]), "+v"(acc[18]), "+v"(acc[27]));
        }
#pragma unroll
        for (int c = 0; c < 36; ++c) { acc[c] = wave_sum(acc[c]); if ((c & 3) == 3) asm volatile("" : "+v"(acc[c - 3]), "+v"(acc[c - 2]), "+v"(acc[c - 1]), "+v"(acc[c])); }
        float gl[4];
#pragma unroll
        for (int j = 0; j < 4; ++j) gl[j] = acc[j] + args.in[15][j];
        int gi = 0; float gm = gl[0];
#pragma unroll
        for (int j = 1; j < 4; ++j) if (gl[j] > gm) { gm = gl[j]; gi = j; }
        float gs = 0.f;
#pragma unroll
        for (int j = 0; j < 4; ++j) gs += __expf(gl[j] - gm);
        const float gval = 1.f / gs;
        float el[8];
#pragma unroll
        for (int j = 0; j < 8; ++j) { const float v = (gi == 0) ? acc[4 + j] : (gi == 1) ? acc[12 + j] : (gi == 2) ? acc[20 + j] : acc[28 + j]; el[j] = v + args.in[17][gi * 8 + j]; }
        int i1 = 0; float v1 = el[0];
#pragma unroll
        for (int j = 1; j < 8; ++j) if (el[j] > v1) { v1 = el[j]; i1 = j; }
        int i2 = (i1 == 0) ? 1 : 0; float v2 = (i1 == 0) ? el[1] : el[0];
#pragma unroll
        for (int j = 1; j < 8; ++j) if (j != i1 && el[j] > v2) { v2 = el[j]; i2 = j; }
        const float w1 = 1.f / (1.f + __expf(v2 - v1)), w2 = 1.f - w1;
        if (lane == 0) {
            const int E1 = gi * 8 + i1, E2 = gi * 8 + i2, slot = F.wave * 8 + ti;
            const unsigned r1 = __hip_atomic_fetch_add(lcnt + E1, 1u, __ATOMIC_RELAXED, __HIP_MEMORY_SCOPE_WORKGROUP), r2 = __hip_atomic_fetch_add(lcnt + E2, 1u, __ATOMIC_RELAXED, __HIP_MEMORY_SCOPE_WORKGROUP);
            rec[slot * 4 + 0] = (unsigned)E1 | ((unsigned)E2 << 8) | (r1 << 16) | (r2 << 24); rec[slot * 4 + 1] = (unsigned)m;
            rec[slot * 4 + 2] = __float_as_uint(gval * w1); rec[slot * 4 + 3] = __float_as_uint(gval * w2);
        }
    }
    __syncthreads();
    if (tid < 32) { const unsigned n = lcnt[tid]; lbase[tid] = n ? atomicAdd(&cnt[tid * CNT_STRIDE], n) : 0u; }
    __syncthreads();
    if (tid < 64) {
        const unsigned r0 = rec[tid * 4], m = rec[tid * 4 + 1]; const unsigned E1 = r0 & 255u, E2 = (r0 >> 8) & 255u, p1 = lbase[E1] + ((r0 >> 16) & 255u), p2 = lbase[E2] + (r0 >> 24);
        if (m < (unsigned)NTOK) {
            lst[(size_t)E1 * NTOK + p1] = m * 2u; lstw[(size_t)E1 * NTOK + p1] = __uint_as_float(rec[tid * 4 + 2]);
            lst[(size_t)E2 * NTOK + p2] = m * 2u + 1u; lstw[(size_t)E2 * NTOK + p2] = __uint_as_float(rec[tid * 4 + 3]);
        }
    }
    __syncthreads();
}
__device__ __forceinline__ void moe_tiles(Frame& F) {
    LAS int* ts = (LAS int*)(F.lds + LDS_TS);
    __syncthreads();
    if (F.tid == 0) { const unsigned* cnt = (const unsigned*)(F.ws + WS_CTL) + CW_CNT; int a = 0; for (int e = 0; e < 32; ++e) { ts[e] = a; a += (int)((__hip_atomic_load(cnt + e * CNT_STRIDE, __ATOMIC_RELAXED, __HIP_MEMORY_SCOPE_AGENT) + 255u) >> 8); } ts[32] = a; }
    __syncthreads();
}
__device__ __forceinline__ void final_phase(Frame& F, const Args& args) {
    const int gw = F.vcu * NWAVES + F.wave, NGW = F.G * NWAVES, lane = F.lane;
    const float* mods = (const float*)(F.ws + WS_MODS); const bf16* Y = (const bf16*)(F.ws + WS_Y);
#pragma unroll 1
    for (int m = gw; m < NTOK; m += NGW) {
        const int b = m >> 12; f32x4* xr = (f32x4*)(F.out + (size_t)m * 1024) + lane;
        const f32x4* g2 = (const f32x4*)(mods + b * 6144 + 5 * 1024) + lane;
        const u32x2* y0 = (const u32x2*)(Y + (size_t)m * 1024) + lane; const u32x2* y1 = (const u32x2*)(Y + ((size_t)NTOK + m) * 1024) + lane;
        f32x4 v[4]; float s = 0.f;
#pragma unroll
        for (int j = 0; j < 4; ++j) { const u32x2 a = y0[64 * j], c = y1[64 * j];
            const f32x4 y = (f32x4){bflo(a.x) + bflo(c.x), bfhi(a.x) + bfhi(c.x), bflo(a.y) + bflo(c.y), bfhi(a.y) + bfhi(c.y)};
            v[j] = xr[64 * j] * ALPHA + g2[64 * j] * y; s += (v[j][0] + v[j][1]) + (v[j][2] + v[j][3]); }
        const float mean = wave_sum(s) * (1.f / 1024.f); float s2 = 0.f;
#pragma unroll
        for (int j = 0; j < 4; ++j) { v[j] = v[j] - mean; s2 += (v[j][0] * v[j][0] + v[j][1] * v[j][1]) + (v[j][2] * v[j][2] + v[j][3] * v[j][3]); }
        const float rstd = rsqrtf(wave_sum(s2) * (1.f / 1024.f) + LN_EPS);
        const f32x4* lg = (const f32x4*)args.in[21] + lane; const f32x4* lb = (const f32x4*)args.in[22] + lane;
#pragma unroll
        for (int j = 0; j < 4; ++j) xr[64 * j] = v[j] * rstd * lg[64 * j] + lb[64 * j];
    }
}

#if NAIVE_ATTN
__device__ __forceinline__ void attn_naive(Frame& F) {
    const int gw = F.vcu * NWAVES + F.wave, NGW = F.G * NWAVES, lane = F.lane;
    LAS float* pl = (LAS float*)(F.lds) + F.wave * 256;
    bf16* QD = (bf16*)(F.ws + WS_QD); const bf16* KD = (const bf16*)(F.ws + WS_KD); const bf16* VD = (const bf16*)(F.ws + WS_VD);
    float* LSE = (float*)(F.ws + WS_LSE); const float* BT = (const float*)(F.ws + WS_BTAB);
#pragma unroll 1
    for (int w = gw; w < NTOK * 24; w += NGW) {
        const int m = w / 24, gh = w % 24, g = gh >> 3, dil = 1 << (2 * g), b = m >> 12, s = m & 4095;
        const bf16* q = QD + (size_t)m * 1536 + gh * 64;
        float sc[3]; float mx = -INFINITY;
#pragma unroll
        for (int p = 0; p < 3; ++p) {
            const int mm = lane + 64 * p; const int sk = s - mm * dil; float v = -INFINITY;
            if (mm <= 128 && sk >= 0) { const bf16* k = KD + (size_t)(b * SEQ + sk) * 1536 + gh * 64; float d = 0.f; for (int e = 0; e < 64; ++e) d += bf2f(q[e]) * bf2f(k[e]); v = d + BT[gh * 132 + mm]; }
            sc[p] = v; mx = fmaxf(mx, v);
        }
#pragma unroll
        for (int o = 1; o < 64; o <<= 1) mx = fmaxf(mx, __shfl_xor(mx, o));
        float sum = 0.f;
#pragma unroll
        for (int p = 0; p < 3; ++p) { const float e = __expf(sc[p] - mx); if (lane + 64 * p < 256) pl[lane + 64 * p] = e; sum += e; }
        sum = wave_sum(sum);
        LDS_WAIT();
        float o = 0.f;
        for (int mm = 0; mm <= 128; ++mm) { const int sk = s - mm * dil; if (sk >= 0) o += pl[mm] * bf2f(VD[(size_t)(b * SEQ + sk) * 1536 + gh * 64 + lane]); }
        LDS_WAIT();
        QD[(size_t)m * 1536 + gh * 64 + lane] = f2bf(o / sum);
        if (lane == 0) LSE[(size_t)m * 24 + gh] = mx + __logf(sum);
    }
    __syncthreads();
}
#endif
#if NAIVE_GLA || DBG_GLA_DIFF
__device__ __forceinline__ void gla_naive(Frame& F, const Args& args) {
    const int tid = F.tid;
    LAS float* A = (LAS float*)F.lds;
    LAS float* Qs = A + 8192; LAS float* Ks = Qs + 8192; LAS float* Vs = Ks + 8192;
    LAS float* Os = Vs + 1024;
    const bf16* QA = (const bf16*)(F.ws + WS_QA); const bf16* KA = (const bf16*)(F.ws + WS_KA); const bf16* VA = (const bf16*)(F.ws + WS_VA);
    const float* LR = (const float*)(F.ws + WS_LR); float* OF = (float*)(F.ws + WS_DS);
    const int U = F.vcu; if (U < 256) {
    const int bh = U >> 4, vt = U & 15, b = bh >> 2, h = bh & 3;
    float st[8];
#pragma unroll
    for (int j = 0; j < 8; ++j) st[j] = 0.f;
    const int v = tid & 15, kg = (tid >> 4) & 15;
    for (int c = 0; c < 64; ++c) {
        const size_t tok0 = (size_t)b * SEQ + c * 64;
        __syncthreads();
        for (int i = tid; i < 8192; i += NTHR) { const int t = i >> 7, k = i & 127; float lg = args.in[7][h * 128 + k];
            for (int j = 0; j < 16; ++j) lg += LR[(tok0 + t) * 16 + j] * args.in[6][j * 512 + h * 128 + k];
            A[i] = __expf(log_sigmoid_(lg) * (1.f / 16.f)); Qs[i] = bf2f(QA[(tok0 + t) * 512 + h * 128 + k]); Ks[i] = bf2f(KA[(tok0 + t) * 512 + h * 128 + k]); }
        for (int i = tid; i < 1024; i += NTHR) { Vs[i] = bf2f(VA[(tok0 + (i >> 4)) * 1024 + h * 256 + vt * 16 + (i & 15)]); Os[i] = 0.f; }
        __syncthreads();
        if (tid < 256) {
            for (int t = 0; t < 64; ++t) { const float vv = Vs[t * 16 + v]; float o = 0.f;
#pragma unroll
                for (int j = 0; j < 8; ++j) { const int k = kg * 8 + j; st[j] = st[j] * A[t * 128 + k] + Ks[t * 128 + k] * vv; o += Qs[t * 128 + k] * st[j]; }
                o += __shfl_xor(o, 16); o += __shfl_xor(o, 32);
                if ((kg & 3) == 0) Os[(tid >> 6) * 1024 + t * 16 + v] = o;
            }
        }
        __syncthreads();
        for (int i = tid; i < 1024; i += NTHR) OF[(tok0 + (i >> 4)) * 1024 + h * 256 + vt * 16 + (i & 15)] = (Os[i] + Os[1024 + i]) + (Os[2048 + i] + Os[3072 + i]);
    }
    }
    __syncthreads();
}
__device__ __forceinline__ void gla_naive_norm(Frame& F, const Args& args, size_t ws_out = WS_YGLA) {
    const int gw = F.vcu * NWAVES + F.wave, NGW = F.G * NWAVES, lane = F.lane;
    const float* OF = (const float*)(F.ws + WS_DS); const bf16* RA = (const bf16*)(F.ws + WS_RA); bf16* YG = (bf16*)(F.ws + ws_out);
#pragma unroll 1
    for (int w = gw; w < NTOK * 4; w += NGW) {
        const size_t e = (size_t)(w >> 2) * 1024 + (w & 3) * 256 + lane * 4; const f32x4 o = *(const f32x4*)(OF + e);
        const float ss = wave_sum(o[0] * o[0] + o[1] * o[1] + o[2] * o[2] + o[3] * o[3]); const float rs = rsqrtf(ss * (1.f / 256.f) + LN_EPS);
        const float* ng = args.in[8] + (w & 3) * 256 + lane * 4;
#pragma unroll
        for (int j = 0; j < 4; ++j) YG[e + j] = f2bf(o[j] * rs * ng[j] * bf2f(RA[e + j]));
    }
}
#endif

enum { PH_P0 = 0, PH_P0B, PH_INPROJ, PH_ATTN, PH_GLAA, PH_SCAN, PH_GLAC, PH_PROJ, PH_OUT, PH_LN1, PH_MOE1, PH_MOE2, PH_FINAL, NPH };

__global__ void __launch_bounds__(NTHR, 2) mega_fwd(Args args) {
    extern __shared__ __attribute__((aligned(16))) unsigned char lds_raw[];
    Frame F;
    F.lds = (LAS unsigned char*)lds_raw;
    F.tid = threadIdx.x; F.lane = F.tid & 63; F.wave = __builtin_amdgcn_readfirstlane(F.tid >> 6);
    F.G = gridDim.x; { const int bx = blockIdx.x; F.vcu = (F.G % 8 == 0) ? (bx % 8) * (F.G / 8) + bx / 8 : bx; }
    F.ws = args.ws; F.out = args.out;
    for (int u = F.tid; u < (LDS_BYTES - LDSCTL_OFF) / 4; u += NTHR) ((LAS unsigned*)(F.lds + LDSCTL_OFF))[u] = 0u;
    __syncthreads();
    const int lo = args.ph_lo, hi = args.ph_hi;
    XcdBarrier bar; bar.bar = (unsigned*)(F.ws + WS_CTL) + CW_BAR; bar.x = 0; bar.st = nullptr;
    if (hi - lo > 1) bar = xcd_barrier_post((unsigned*)(F.ws + WS_CTL) + CW_BAR, (volatile LAS unsigned*)(F.lds + LDSCTL_OFF));
#ifndef PHASE_MASK
#define PHASE_MASK 0xFFFF
#endif
#define IN(k) (((PHASE_MASK >> (k)) & 1) && lo <= (k) && (k) < hi)
#define SEAM(k) do { if (IN(k) && IN((k) + 1)) xcd_barrier(bar); } while (0)
    unsigned char* ws = F.ws;
    bf16* GA = (bf16*)F.out; bf16* GD = GA + (size_t)NTOK * 1024;

    if (IN(PH_P0)) { frame_refresh(F); p0_phase(F, args); } SEAM(PH_P0);
    if (IN(PH_P0B)) { frame_refresh(F); p0b_phase(F, args); } SEAM(PH_P0B);
    if (IN(PH_INPROJ)) { frame_refresh(F);
        pg8::DenseOrder S; S.init(NTOK, INPAD, 1024, F.G, (int)blockIdx.x);
        run_gemm(F, (const bf16*)(ws + WS_U), (const bf16*)(ws + WS_WIN), 1024, S, EpiInProj{ws, GA, GD});
    } SEAM(PH_INPROJ);
    if (IN(PH_ATTN)) { frame_refresh(F);
#if NAIVE_ATTN
        attn_naive(F);
#else
        attn_phase(F);
#endif
    } SEAM(PH_ATTN);
    if (IN(PH_GLAA)) { frame_refresh(F);
#if NAIVE_GLA
        gla_naive(F, args);
#else
        gla_a_phase(F, args);
#endif
        combine_phase(F);
    } SEAM(PH_GLAA);
    if (IN(PH_SCAN)) { frame_refresh(F);
#if !NAIVE_GLA
        gla_scan_phase(F);
#endif
    } SEAM(PH_SCAN);
    if (IN(PH_GLAC)) { frame_refresh(F);
#if NAIVE_GLA
        gla_naive_norm(F, args);
#else
        gla_c_phase(F, args);
#endif
    } SEAM(PH_GLAC);
    if (IN(PH_PROJ)) { frame_refresh(F);
        pg8::DenseOrder S; S.init(NTOK, 1024, 512, F.G, (int)blockIdx.x);
        run_gemm(F, (const bf16*)(ws + WS_YATT), (const bf16*)(ws + WS_WPA), 512, S, EpiProjA{GD, (bf16*)(ws + WS_TT)});
        VM_WAIT(); __syncthreads();
        pg8::DenseOrder S2; S2.init(NTOK, 1024, 1024, F.G, (int)blockIdx.x);
        run_gemm(F, (const bf16*)(ws + WS_YGLA), (const bf16*)(ws + WS_WPG), 1024, S2, EpiProjG{GA, (const bf16*)(ws + WS_TT), (bf16*)(ws + WS_MERGED)});
        convert_experts(F, args);
    } SEAM(PH_PROJ);
    if (IN(PH_OUT)) { frame_refresh(F);
        pg8::DenseOrder S; S.init(NTOK, 1024, 1024, F.G, (int)blockIdx.x);
        run_gemm(F, (const bf16*)(ws + WS_MERGED), (const bf16*)(ws + WS_WOUT), 1024, S, EpiOut{args.in[0], (const float*)(ws + WS_MODS), F.out});
    } SEAM(PH_OUT);
    if (IN(PH_LN1)) { frame_refresh(F); ln1_router_phase(F, args); } SEAM(PH_LN1);
    if (IN(PH_MOE1)) { frame_refresh(F);
        moe_tiles(F);
        MoeOrder S{(const LAS int*)(F.lds + LDS_TS), (const unsigned*)(ws + WS_CTL) + CW_CNT, (const unsigned*)(ws + WS_LST), F.G, F.vcu, 0};
        run_gemm(F, (const bf16*)(ws + WS_U2), (const bf16*)(ws + WS_WGU), 1024, S, EpiMoeUp{(bf16*)(ws + WS_H)});
    } SEAM(PH_MOE1);
    if (IN(PH_MOE2)) { frame_refresh(F);
        moe_tiles(F);
        MoeOrder S{(const LAS int*)(F.lds + LDS_TS), (const unsigned*)(ws + WS_CTL) + CW_CNT, (const unsigned*)(ws + WS_LST), F.G, F.vcu, 1};
        run_gemm(F, (const bf16*)(ws + WS_H), (const bf16*)(ws + WS_WDN), 512, S, EpiMoeDown{(const unsigned*)(ws + WS_CTL) + CW_CNT, (const unsigned*)(ws + WS_LST), (const float*)(ws + WS_LSTW), (bf16*)(ws + WS_Y)});
    } SEAM(PH_MOE2);
    if (IN(PH_FINAL)) { frame_refresh(F); final_phase(F, args); }
#if DBG_GLA_DIFF
    if (lo == 13) { frame_refresh(F); gla_naive(F, args); }
    if (lo == 14) { frame_refresh(F); gla_naive_norm(F, args, WS_TT); }
    if (lo == 15) { frame_refresh(F);
        const bf16* ya = (const bf16*)(ws + DBG_SRC);
        for (size_t i = (size_t)blockIdx.x * NTHR + F.tid; i < (size_t)NTOK * 1024; i += (size_t)F.G * NTHR) { float d = bf2f(ya[i]); if (!(fabsf(d) < 1e30f)) d = 1e4f; F.out[i] = d; } }
#endif
#undef IN
#undef SEAM
}

extern "C" void kernel_launch(void* const* d_in, const int* in_sizes, int n_in, void* d_out, int out_size, void* d_ws, size_t ws_size, hipStream_t stream) {
    static int grid = 0;
    if (grid == 0) {
        if (n_in != 23 || out_size != NTOK * D || ws_size < WS_END) { fprintf(stderr, "kernel_launch: unexpected shapes (n_in %d out %d ws %zu, need %zu)\n", n_in, out_size, ws_size, (size_t)WS_END); grid = -1; return; }
        int dev = 0, cus = 0;
        if (hipGetDevice(&dev) != hipSuccess || hipDeviceGetAttribute(&cus, hipDeviceAttributeMultiprocessorCount, dev) != hipSuccess) { grid = -1; return; }
        if (hipFuncSetAttribute((const void*)mega_fwd, hipFuncAttributeMaxDynamicSharedMemorySize, LDS_BYTES) != hipSuccess) { fprintf(stderr, "kernel_launch: hipFuncSetAttribute failed\n"); grid = -1; return; }
        int per_cu = 0;
        if (hipOccupancyMaxActiveBlocksPerMultiprocessor(&per_cu, (const void*)mega_fwd, NTHR, LDS_BYTES) != hipSuccess || per_cu < 1) fprintf(stderr, "kernel_launch: occupancy query reports %d\n", per_cu);
        (void)hipGetLastError();
        grid = cus - (cus % 8);
        if (grid <= 0) grid = cus;
    }
    if (grid < 0) return;
    (void)hipMemsetAsync((char*)d_ws + WS_CTL, 0, CTL_ZERO_BYTES, stream);
    Args a{};
    for (int i = 0; i < 23; ++i) a.in[i] = (const float*)d_in[i];
    a.out = (float*)d_out; a.ws = (unsigned char*)d_ws;
#if DBG_GLA_DIFF
    { const int seq[] = DBG_SEQ;
      for (int k = 0; k < (int)(sizeof(seq) / sizeof(int)); ++k) { a.ph_lo = seq[k]; a.ph_hi = seq[k] + 1; hipLaunchKernelGGL(mega_fwd, dim3(grid), dim3(NTHR), LDS_BYTES, stream, a); } }
#elif MK_MULTI
    { const int seq[] = MULTI_SEQ;
      for (int k = 0; k < (int)(sizeof(seq) / sizeof(int)); ++k) { a.ph_lo = seq[k]; a.ph_hi = seq[k] + 1; hipLaunchKernelGGL(mega_fwd, dim3(grid), dim3(NTHR), LDS_BYTES, stream, a); } }
#else
    a.ph_lo = 0; a.ph_hi = NPH;
    hipLaunchKernelGGL(mega_fwd, dim3(grid), dim3(NTHR), LDS_BYTES, stream, a);
#endif
}
```

```cpp
#include <hip/hip_runtime.h>
#include <cstdio>
#include <cstdint>

#ifndef MK_MULTI
#define MK_MULTI 0
#endif
#ifndef MULTI_SEQ
#define MULTI_SEQ {0, 1, 2, 3, 4, 5, 6, 7, 8, 9, 10, 11, 12}
#endif
#ifndef DBG_GLA_DIFF
#define DBG_GLA_DIFF 0
#define DBG_SEQ {0, 1, 2, 3, 4, 15}
#define DBG_SRC WS_DS
#endif
#ifndef NAIVE_GEMM
#define NAIVE_GEMM 0
#endif
#ifndef NAIVE_ATTN
#define NAIVE_ATTN 0
#endif
#ifndef NAIVE_GLA
#define NAIVE_GLA 0
#endif

#define GAS __attribute__((address_space(1)))
#define LAS __attribute__((address_space(3)))
typedef unsigned short bf16;
typedef short bf16x8 __attribute__((ext_vector_type(8)));
typedef short s16x4 __attribute__((ext_vector_type(4)));
typedef float f32x4 __attribute__((ext_vector_type(4)));
typedef float f32x16 __attribute__((ext_vector_type(16)));
typedef unsigned u32x4 __attribute__((ext_vector_type(4)));
typedef unsigned u32x2 __attribute__((ext_vector_type(2)));

constexpr int NB = 4, SEQ = 4096, NTOK = NB * SEQ, D = 1024;
constexpr int NWAVES = 8, NTHR = 512;
constexpr int INCOLS = 9744, INPAD = 9984;
constexpr float LN_EPS = 1e-5f;
constexpr float ALPHA = 1.189207115002721f;
constexpr int C_QA = 0, C_KA = 512, C_VA = 1024, C_RA = 2048, C_QD = 3072, C_KD = 4608, C_VD = 6144, C_GA = 7680, C_GD = 8704, C_LR = 9728;

constexpr size_t MiB = 1u << 20;
constexpr size_t WS_CTL = 0, CTL_ZERO_BYTES = 256 * 1024;
constexpr size_t WS_MODS = 1 * MiB;
constexpr size_t WS_BTAB = WS_MODS + 128 * 1024;
constexpr size_t WS_WRT = WS_MODS + 256 * 1024;
constexpr size_t WS_WIN = 2 * MiB;
constexpr size_t WS_WPG = 22 * MiB, WS_WPA = 24 * MiB, WS_WOUT = 25 * MiB;
constexpr size_t WS_LR = 27 * MiB;
constexpr size_t WS_LSE = 28 * MiB;
constexpr size_t WS_DECAY = 318 * MiB;
constexpr size_t WS_QA = 30 * MiB, WS_KA = 46 * MiB, WS_VA = 62 * MiB, WS_RA = 94 * MiB;
constexpr size_t WS_QD = 126 * MiB, WS_KD = 174 * MiB, WS_VD = 222 * MiB;
constexpr size_t WS_U = 270 * MiB;
constexpr size_t WS_YGLA = 270 * MiB, WS_YATT = 302 * MiB;
constexpr size_t WS_DS = 174 * MiB;
constexpr size_t WS_MERGED = 30 * MiB;
constexpr size_t WS_T = 222 * MiB;
constexpr size_t WS_TT = 238 * MiB;
constexpr size_t WS_WGU = 126 * MiB;
constexpr size_t WS_WDN = 190 * MiB;
constexpr size_t WS_U2 = 62 * MiB;
constexpr size_t WS_LST = 94 * MiB;
constexpr size_t WS_LSTW = 96 * MiB;
constexpr size_t WS_H = 222 * MiB;
constexpr size_t WS_Y = 262 * MiB;
constexpr size_t WS_END = 326 * MiB;

constexpr int CW_CNT = 8192, CNT_STRIDE = 64;
constexpr int CW_BAR = 1024;

constexpr int LDS_BYTES = 163840;
constexpr int LDSCTL_OFF = 157696;
constexpr int LDS_TS = LDSCTL_OFF + 64;

#define LDS_WAIT() asm volatile("s_waitcnt lgkmcnt(0)" ::: "memory")
#define VM_WAIT() asm volatile("s_waitcnt vmcnt(0)" ::: "memory")

typedef float f32x2_t __attribute__((ext_vector_type(2))); typedef __bf16 bf16x2_t __attribute__((ext_vector_type(2)));
__device__ __forceinline__ unsigned pk2(float lo, float hi) { f32x2_t v = {lo, hi}; bf16x2_t b = __builtin_convertvector(v, bf16x2_t); return __builtin_bit_cast(unsigned, b); }
__device__ __forceinline__ bf16 f2bf(float x) { return (bf16)(pk2(x, 0.f) & 0xffffu); }
__device__ __forceinline__ float bf2f(unsigned short u) { return __uint_as_float(((unsigned)u) << 16); }
__device__ __forceinline__ float bflo(unsigned w) { return __uint_as_float(w << 16); }
__device__ __forceinline__ float bfhi(unsigned w) { return __uint_as_float(w & 0xffff0000u); }
__device__ __forceinline__ float sigmoidf_(float x) { return __builtin_amdgcn_rcpf(1.f + __expf(-x)); }
__device__ __forceinline__ float siluf_(float x) { return x * __builtin_amdgcn_rcpf(1.f + __expf(-x)); }
__device__ __forceinline__ float wave_sum(float v) {
#pragma unroll
    for (int o = 1; o < 64; o <<= 1) v += __shfl_xor(v, o);
    return v;
}
__device__ __forceinline__ int crow(int r, int hi) { return (r & 3) + 8 * (r >> 2) + 4 * hi; }

#define XB_TMO      128
#define XB_XCNT(j)  (256  + 64 * (j))
#define XB_XSUB(j)  (1280 + 64 * (j))
#define XB_XGEN(j)  (2304 + 64 * (j))
#define XB_TOP      3328
#define XB_TOPGEN   3392
#define XCD_BAR_WORDS 3456
#define XB_SPIN_CAP (1u << 18)
__device__ __forceinline__ unsigned xb_ld(unsigned* p)              { return __hip_atomic_load(p, __ATOMIC_RELAXED, __HIP_MEMORY_SCOPE_AGENT); }
__device__ __forceinline__ unsigned xb_add(unsigned* p, unsigned v) { return __hip_atomic_fetch_add(p, v, __ATOMIC_RELAXED, __HIP_MEMORY_SCOPE_AGENT); }
__device__ __forceinline__ unsigned xb_xcc_id() { return (unsigned)__builtin_amdgcn_s_getreg((3 << 11) | 20) & 0xFu; }
#define XB_SPIN(cond, bar) do { unsigned _sp = 0; while (cond) { __builtin_amdgcn_s_sleep(1); \
    if ((++_sp & 255u) == 0u) { if (xb_ld(&(bar)[XB_TMO])) break; if (_sp > XB_SPIN_CAP) { atomicAdd(&(bar)[XB_TMO], 1u); break; } } } } while (0)
struct XcdBarrier { unsigned* bar; unsigned x; volatile LAS unsigned* st; };
__device__ __forceinline__ XcdBarrier xcd_barrier_post(unsigned* bar, volatile LAS unsigned* st) {
    XcdBarrier b; b.bar = bar; b.x = xb_xcc_id(); b.st = st;
    if (threadIdx.x == 0) (void)xb_add(&bar[XB_XCNT(b.x)], 1u);
    return b;
}
__device__ __forceinline__ void xcd_barrier_complete(unsigned* bar, unsigned x, unsigned& nloc, unsigned& nx) {
    const unsigned G = gridDim.x * gridDim.y * gridDim.z;
    unsigned sum, cnt, mine, sp = 0u;
    for (;;) {
        sum = 0u; cnt = 0u; mine = 0u;
#pragma unroll
        for (unsigned j = 0; j < 16; ++j) { const unsigned c = xb_ld(&bar[XB_XCNT(j)]); sum += c; cnt += (c > 0u) ? 1u : 0u; mine = (j == x) ? c : mine; }
        if (sum == G) break;
        __builtin_amdgcn_s_sleep(1);
        if ((++sp & 255u) == 0u) { if (xb_ld(&bar[XB_TMO])) break; if (sp > XB_SPIN_CAP) { atomicAdd(&bar[XB_TMO], 1u); break; } }
    }
    nloc = mine > 0u ? mine : 1u; nx = cnt > 0u ? cnt : 1u;
}
__device__ __forceinline__ void xcd_barrier(const XcdBarrier& b) {
    asm volatile("s_waitcnt vmcnt(0)" ::: "memory");
    __syncthreads();
    if (threadIdx.x == 0) {
        unsigned* bar = b.bar;
        __builtin_amdgcn_s_waitcnt(0);
        unsigned nloc = b.st[0], nx = b.st[1];
        if (nloc == 0u) { xcd_barrier_complete(bar, b.x, nloc, nx); b.st[0] = nloc; b.st[1] = nx; }
        const unsigned old = xb_add(&bar[XB_XSUB(b.x)], 1u);
        const unsigned gen = old / nloc;
        if (old + 1u == (gen + 1u) * nloc) {
            __builtin_amdgcn_fence(__ATOMIC_RELEASE, "agent");
            asm volatile("s_waitcnt vmcnt(0)" ::: "memory");
            const unsigned og = xb_add(&bar[XB_TOP], 1u);
            const unsigned tg = og / nx;
            if (og + 1u == (tg + 1u) * nx) xb_add(&bar[XB_TOPGEN], 1u);
            else XB_SPIN(xb_ld(&bar[XB_TOPGEN]) == tg, bar);
            __builtin_amdgcn_fence(__ATOMIC_ACQUIRE, "agent");
            xb_add(&bar[XB_XGEN(b.x)], 1u);
            asm volatile("s_waitcnt vmcnt(0)" ::: "memory");
        } else {
            XB_SPIN(xb_ld(&bar[XB_XGEN(b.x)]) == gen, bar);
            __builtin_amdgcn_fence(__ATOMIC_ACQUIRE, "agent");
            asm volatile("s_waitcnt vmcnt(0)" ::: "memory");
        }
    }
    __syncthreads();
}

struct Args { const float* in[23]; float* out; unsigned char* ws; int ph_lo, ph_hi; };
struct Frame {
    LAS unsigned char* lds;
    int tid, lane, wave, vcu, G;
    unsigned char* ws; float* out;
};
__device__ __forceinline__ void frame_refresh(Frame& F) { int t = threadIdx.x; asm volatile("" : "+v"(t)); F.tid = t; F.lane = t & 63; }

namespace pg8 {
constexpr int BM = 256, BK = 64, HALF = 128, HTB = HALF * BK * 2, STAGE_BYTES = 8 * HTB, NXCD = 8, WGM = 8;
__host__ __device__ __forceinline__ int lds_byte(int r, int c) { const int st = (r >> 4) * 2 + (c >> 5), rr = r & 15, cc = c & 31, ob = rr * 64 + cc * 2; return st * 1024 + (ob ^ (((ob >> 9) & 1) << 5)); }
__host__ __device__ __forceinline__ void stage_rc(int b, int& R, int& C) { const int st = b / 1024, sb = b % 1024, swz = sb ^ (((sb >> 9) & 1) << 5); R = (st >> 1) * 16 + swz / 64; C = (st & 1) * 32 + (swz % 64) / 2; }
__host__ __device__ __forceinline__ int perm32(int rho) { const int n = rho >> 4, i = rho & 15; return 8 * (i >> 2) + 4 * n + (i & 3); }

struct Unit { int pm, pn, e, mt; };

struct DenseOrder {
    static constexpr bool GATHER = false;
    int nM, nN, nwg, G, c, K;
    __device__ void init(int M, int N, int K_, int G_, int c_) { nM = M / BM; nN = N / BM; nwg = nM * nN; G = G_; c = c_; K = K_; }
    __device__ __forceinline__ bool next(int i, Unit& u) const {
        const long L = (long)i * G + c; if (L >= nwg) return false;
        int wgid = (int)L; { const int q = nwg / NXCD, r = nwg % NXCD, xcd = wgid % NXCD, off = wgid / NXCD; wgid = (xcd < r ? xcd * (q + 1) : r * (q + 1) + (xcd - r) * q) + off; }
        const int nig = WGM * nN, gid = wgid / nig, fm = gid * WGM, gsz = (nM - fm) < WGM ? (nM - fm) : WGM;
        u.pm = fm + ((wgid % nig) % gsz); u.pn = (wgid % nig) / gsz; u.e = 0; u.mt = 0; return true;
    }
    __device__ __forceinline__ size_t a_base(const Unit& u) const { return (size_t)u.pm * BM * K * 2; }
    __device__ __forceinline__ unsigned a_lane(const Unit&, int r) const { return (unsigned)r * (unsigned)K * 2u; }
    __device__ __forceinline__ size_t b_off(const Unit& u) const { return (size_t)u.pn * BM * K * 2; }
};

template <class Epi, class Sched>
__device__ __forceinline__ void gemm_phase(LAS unsigned char* lds, const bf16* Aptr, const bf16* Bptr, int K, const Sched& S, const Epi& E) {
    int tid_ = threadIdx.x; asm volatile("" : "+v"(tid_));
    const int tid = tid_, wid = __builtin_amdgcn_readfirstlane(tid >> 6), lane = tid & 63, wr = wid >> 2, wc = wid & 3, fr = lane & 15, fq = lane >> 4;
    const int nt = K / BK;
    int RA[2]; unsigned CA2[2], voffB[2];
#pragma unroll
    for (int i = 0; i < 2; ++i) { int R, C; stage_rc(tid * 16 + i * 8192, R, C); const int Rb = (R & ~31) + perm32(R & 31);
        RA[i] = R; CA2[i] = (unsigned)C * 2u; voffB[i] = (unsigned)(Rb * K + C) * 2u; }
    const size_t kstep = (size_t)(BK * 2);
    const size_t hstep = (size_t)HALF * K * 2;
    const unsigned ldsw = (unsigned)wid * 1024u;
    const int aoff = lds_byte(wr * 64 + fr, fq * 8), boff = lds_byte(wc * 32 + fr, fq * 8);
    const char* Abase = (const char*)Aptr;
#define PG8_SA(b, h) (((b) * 2 + (h)) * HTB)
#define PG8_SB(b, h) ((4 + (b) * 2 + (h)) * HTB)
#define PG8_STAGE(bufoff, gbase, voff) do { _Pragma("unroll") for (int _i = 0; _i < 2; ++_i) \
        __builtin_amdgcn_global_load_lds((const unsigned*)((const char*)(gbase) + (voff)[_i]), (LAS unsigned*)(lds + (bufoff) + ldsw + _i * 8192), 16, 0, 0); } while (0)
#define PG8_LDA(dst, b, h) do { _Pragma("unroll") for (int m = 0; m < 4; ++m) _Pragma("unroll") for (int k = 0; k < 2; ++k) dst[m][k] = *(const LAS bf16x8*)(lds + PG8_SA(b, h) + aoff + m * 2048 + k * 1024); } while (0)
#define PG8_LDB(dst, b, h) do { _Pragma("unroll") for (int n = 0; n < 2; ++n) _Pragma("unroll") for (int k = 0; k < 2; ++k) dst[n][k] = *(const LAS bf16x8*)(lds + PG8_SB(b, h) + boff + n * 2048 + k * 1024); } while (0)
#define PG8_MMA(ai, bj, At, Bt) do { __builtin_amdgcn_s_setprio(1); _Pragma("unroll") for (int m = 0; m < 4; ++m) _Pragma("unroll") for (int n = 0; n < 2; ++n) _Pragma("unroll") for (int k = 0; k < 2; ++k) \
        acc[ai][bj][m][n] = __builtin_amdgcn_mfma_f32_16x16x32_bf16(Bt[n][k], At[m][k], acc[ai][bj][m][n], 0, 0, 0); __builtin_amdgcn_s_setprio(0); } while (0)
#define PG8_WAIT_V(n) asm volatile("s_waitcnt vmcnt(" #n ")" ::: "memory")
#define PG8_WAIT_L(n) asm volatile("s_waitcnt lgkmcnt(" #n ")" ::: "memory")
#define PG8_BAR __builtin_amdgcn_s_barrier()
#define PG8_SCHED __builtin_amdgcn_sched_barrier(0)
    Unit cur, nxt; int ui = 0;
    if (!S.next(0, cur)) return;
    f32x4 acc[2][2][4][2];
#pragma unroll
    for (int a = 0; a < 2; ++a)
#pragma unroll
        for (int b = 0; b < 2; ++b)
#pragma unroll
            for (int m = 0; m < 4; ++m)
#pragma unroll
                for (int n = 0; n < 2; ++n) acc[a][b][m][n] = (f32x4){0.f, 0.f, 0.f, 0.f};
    bf16x8 At[4][2], B0[2][2], B1[2][2];
    unsigned vA0[2], vA1[2], nA0[2], nA1[2];
#pragma unroll
    for (int i = 0; i < 2; ++i) { vA0[i] = S.a_lane(cur, RA[i]) + CA2[i]; vA1[i] = S.a_lane(cur, HALF + RA[i]) + CA2[i]; }
    const char* cB = (const char*)Bptr + S.b_off(cur);
    const char* cA = Abase + S.a_base(cur);
    if (Sched::GATHER) VM_WAIT();
    PG8_STAGE(PG8_SB(0, 0), cB, voffB); PG8_STAGE(PG8_SB(0, 1), cB + hstep, voffB); PG8_STAGE(PG8_SA(0, 0), cA, vA0); PG8_STAGE(PG8_SA(0, 1), cA, vA1);
    if (wr == 1) PG8_BAR;
    PG8_WAIT_V(2); PG8_BAR;
    PG8_STAGE(PG8_SB(1, 0), cB + kstep, voffB); PG8_STAGE(PG8_SA(1, 0), cA + kstep, vA0); PG8_STAGE(PG8_SB(1, 1), cB + hstep + kstep, voffB);
    PG8_WAIT_V(6); PG8_BAR;
    for (;;) {
        const bool has_next = S.next(ui + 1, nxt);
        const char* nB = cB; const char* nA = cA;
        if (has_next) {
            int t2 = tid; if (Sched::GATHER) asm volatile("" : "+v"(t2));
#pragma unroll
            for (int i = 0; i < 2; ++i) { int R, C; stage_rc(t2 * 16 + i * 8192, R, C); nA0[i] = S.a_lane(nxt, R) + (unsigned)C * 2u; nA1[i] = S.a_lane(nxt, HALF + R) + (unsigned)C * 2u; }
            nB = (const char*)Bptr + S.b_off(nxt); nA = Abase + S.a_base(nxt);
            if (Sched::GATHER) VM_WAIT();
        } else {
#pragma unroll
            for (int i = 0; i < 2; ++i) { nA0[i] = vA0[i]; nA1[i] = vA1[i]; }
        }
        for (int t = 0; t < nt; t += 2) {
            const bool last = (t == nt - 2);
            const size_t k1 = (size_t)(t + 1) * kstep;
            const size_t k2 = (size_t)(t + 2) * kstep;
            unsigned w0[2], w1[2];
#pragma unroll
            for (int i = 0; i < 2; ++i) { w0[i] = last ? nA0[i] : vA0[i]; w1[i] = last ? nA1[i] : vA1[i]; }
            const char* b2 = last ? nB : cB + (size_t)(t + 2) * kstep; const char* b3 = b2 + kstep;
            const char* a1p = cA + k1; const char* a2p = last ? nA : cA + k2; const char* a3p = a2p + kstep;
            PG8_LDB(B0, 0, 0); PG8_LDB(B1, 0, 1); PG8_SCHED; PG8_LDA(At, 0, 0); PG8_STAGE(PG8_SA(1, 1), a1p, vA1);
            PG8_WAIT_V(8); PG8_WAIT_L(0); PG8_BAR; PG8_MMA(0, 0, At, B0); PG8_MMA(0, 1, At, B1); PG8_BAR; PG8_SCHED;
            PG8_LDA(At, 0, 1); PG8_STAGE(PG8_SB(0, 0), b2, voffB); PG8_STAGE(PG8_SB(0, 1), b2 + hstep, voffB); PG8_STAGE(PG8_SA(0, 0), a2p, w0);
            PG8_WAIT_V(8); PG8_WAIT_L(0); PG8_BAR; PG8_MMA(1, 0, At, B0); PG8_MMA(1, 1, At, B1); PG8_BAR; PG8_SCHED;
            PG8_LDB(B0, 1, 0); PG8_LDB(B1, 1, 1); PG8_SCHED; PG8_LDA(At, 1, 0); PG8_STAGE(PG8_SA(0, 1), a2p, w1);
            PG8_WAIT_V(8); PG8_WAIT_L(0); PG8_BAR; PG8_MMA(0, 0, At, B0); PG8_MMA(0, 1, At, B1); PG8_BAR; PG8_SCHED;
            PG8_LDA(At, 1, 1); PG8_STAGE(PG8_SB(1, 0), b3, voffB); PG8_STAGE(PG8_SB(1, 1), b3 + hstep, voffB); PG8_STAGE(PG8_SA(1, 0), a3p, w0);
            PG8_WAIT_V(8); PG8_WAIT_L(0); PG8_BAR; PG8_MMA(1, 0, At, B0); PG8_MMA(1, 1, At, B1); PG8_BAR; PG8_SCHED;
        }
        if (wr == 0) PG8_BAR;
        E(acc, cur, wr, wc, fr, fq);
        if (!has_next) break;
#pragma unroll
        for (int a = 0; a < 2; ++a)
#pragma unroll
            for (int b = 0; b < 2; ++b)
#pragma unroll
                for (int m = 0; m < 4; ++m)
#pragma unroll
                    for (int n = 0; n < 2; ++n) acc[a][b][m][n] = (f32x4){0.f, 0.f, 0.f, 0.f};
        cur = nxt; cB = nB; cA = nA; ++ui;
#pragma unroll
        for (int i = 0; i < 2; ++i) { vA0[i] = nA0[i]; vA1[i] = nA1[i]; }
        if (wr == 1) PG8_BAR;
    }
    PG8_WAIT_V(0);
    PG8_BAR;
#undef PG8_SA
#undef PG8_SB
#undef PG8_STAGE
#undef PG8_LDA
#undef PG8_LDB
#undef PG8_MMA
#undef PG8_WAIT_V
#undef PG8_WAIT_L
#undef PG8_BAR
#undef PG8_SCHED
}

template <class Epi, class Sched>
__device__ __forceinline__ void gemm_naive(const bf16* Aptr, const bf16* Bptr, int K, const Sched& S, const Epi& E) {
    Unit u;
    for (int i = 0; S.next(i, u); ++i) {
        const char* cB = (const char*)Bptr + S.b_off(u);
        for (int ch = threadIdx.x; ch < 256 * 32; ch += NTHR) {
            const int r = ch >> 5, c = (ch & 31) * 8;
            const bf16* a = (const bf16*)((const char*)Aptr + S.a_base(u) + S.a_lane(u, r));
            float s[8];
#pragma unroll
            for (int j = 0; j < 8; ++j) s[j] = 0.f;
            for (int k = 0; k < K; k += 8) {
                const u32x4 av = *(const u32x4*)(a + k);
                float af[8] = {bflo(av.x), bfhi(av.x), bflo(av.y), bfhi(av.y), bflo(av.z), bfhi(av.z), bflo(av.w), bfhi(av.w)};
#pragma unroll
                for (int j = 0; j < 8; ++j) {
                    const u32x4 bv = *(const u32x4*)((const bf16*)cB + (size_t)(c + j) * K + k);
                    s[j] += af[0] * bflo(bv.x) + af[1] * bfhi(bv.x) + af[2] * bflo(bv.y) + af[3] * bfhi(bv.y) + af[4] * bflo(bv.z) + af[5] * bfhi(bv.z) + af[6] * bflo(bv.w) + af[7] * bfhi(bv.w);
                }
            }
            E.chunk(u, r, c, (f32x4){s[0], s[1], s[2], s[3]}, (f32x4){s[4], s[5], s[6], s[7]});
        }
    }
}

template <class F> struct EpiWrap {
    F f;
    __device__ __forceinline__ void operator()(const f32x4 (&acc)[2][2][4][2], const Unit& u, int wr, int wc, int fr, int fq) const {
#pragma unroll
        for (int ai = 0; ai < 2; ++ai)
#pragma unroll
            for (int m = 0; m < 4; ++m) {
                const int r = ai * HALF + wr * 64 + m * 16 + fr;
#pragma unroll
                for (int bj = 0; bj < 2; ++bj) f.chunk(u, r, bj * HALF + wc * 32 + 8 * fq, acc[ai][bj][m][0], acc[ai][bj][m][1]);
            }
    }
    __device__ __forceinline__ void chunk(const Unit& u, int r, int c, f32x4 v0, f32x4 v1) const { f.chunk(u, r, c, v0, v1); }
};
}
using pg8::Unit;

template <class F, class Sched>
__device__ __forceinline__ void run_gemm(Frame& Fm, const bf16* A, const bf16* Bt, int K, const Sched& S, const F& f) {
    pg8::EpiWrap<F> E{f};
#if NAIVE_GEMM
    pg8::gemm_naive(A, Bt, K, S, E);
    VM_WAIT(); __syncthreads();
#else
    pg8::gemm_phase(Fm.lds, A, Bt, K, S, E);
#endif
}

__device__ __forceinline__ u32x4 pack8(f32x4 a, f32x4 b) { u32x4 w; w.x = pk2(a[0], a[1]); w.y = pk2(a[2], a[3]); w.z = pk2(b[0], b[1]); w.w = pk2(b[2], b[3]); return w; }
__device__ __forceinline__ void unpack8(u32x4 w, f32x4& a, f32x4& b) { a = (f32x4){bflo(w.x), bfhi(w.x), bflo(w.y), bfhi(w.y)}; b = (f32x4){bflo(w.z), bfhi(w.z), bflo(w.w), bfhi(w.w)}; }

struct EpiInProj {
    unsigned char* ws; bf16* ga; bf16* gd;
    __device__ __forceinline__ void chunk(const Unit& u, int r, int c, f32x4 v0, f32x4 v1) const {
        const int row = u.pm * 256 + r, col = u.pn * 256 + c;
        bf16* dst; float sc = 1.f; int act = 0;
        if (col < C_KA)      { dst = (bf16*)(ws + WS_QA) + (size_t)row * 512 + (col - C_QA); sc = 0.08838834764831845f; }
        else if (col < C_VA) { dst = (bf16*)(ws + WS_KA) + (size_t)row * 512 + (col - C_KA); }
        else if (col < C_RA) { dst = (bf16*)(ws + WS_VA) + (size_t)row * 1024 + (col - C_VA); }
        else if (col < C_QD) { dst = (bf16*)(ws + WS_RA) + (size_t)row * 1024 + (col - C_RA); act = 1; }
        else if (col < C_KD) { dst = (bf16*)(ws + WS_QD) + (size_t)row * 1536 + (col - C_QD); sc = 0.125f; }
        else if (col < C_VD) { dst = (bf16*)(ws + WS_KD) + (size_t)row * 1536 + (col - C_KD); }
        else if (col < C_GA) { dst = (bf16*)(ws + WS_VD) + (size_t)row * 1536 + (col - C_VD); }
        else if (col < C_GD) { dst = ga + (size_t)row * 1024 + (col - C_GA); act = 2; }
        else if (col < C_LR) { dst = gd + (size_t)row * 1024 + (col - C_GD); act = 2; }
        else {
            if (col < C_LR + 16) { float* l = (float*)(ws + WS_LR) + (size_t)row * 16 + (col - C_LR); *(f32x4*)l = v0; *(f32x4*)(l + 4) = v1; }
            return;
        }
        if (act == 1) {
#pragma unroll
            for (int j = 0; j < 4; ++j) { v0[j] = siluf_(v0[j]); v1[j] = siluf_(v1[j]); }
        } else if (act == 2) {
#pragma unroll
            for (int j = 0; j < 4; ++j) { v0[j] = sigmoidf_(v0[j]); v1[j] = sigmoidf_(v1[j]); }
        } else { v0 = v0 * sc; v1 = v1 * sc; }
        *(u32x4*)dst = pack8(v0, v1);
    }
};
struct EpiProjA {
    const bf16* gd; bf16* T;
    __device__ __forceinline__ void chunk(const Unit& u, int r, int c, f32x4 v0, f32x4 v1) const {
        const size_t o = (size_t)(u.pm * 256 + r) * 1024 + u.pn * 256 + c;
        f32x4 g0, g1; unpack8(*(const u32x4*)(gd + o), g0, g1);
        *(u32x4*)(T + o) = pack8(v0 * g0, v1 * g1);
    }
};
struct EpiProjG {
    const bf16* ga; const bf16* T; bf16* merged;
    __device__ __forceinline__ void chunk(const Unit& u, int r, int c, f32x4 v0, f32x4 v1) const {
        const size_t o = (size_t)(u.pm * 256 + r) * 1024 + u.pn * 256 + c;
        f32x4 g0, g1, t0, t1; unpack8(*(const u32x4*)(ga + o), g0, g1); unpack8(*(const u32x4*)(T + o), t0, t1);
        *(u32x4*)(merged + o) = pack8(v0 * g0 + t0, v1 * g1 + t1);
    }
};
struct EpiOut {
    const float* x; const float* mods; float* t1;
    __device__ __forceinline__ void chunk(const Unit& u, int r, int c, f32x4 v0, f32x4 v1) const {
        const int row = u.pm * 256 + r, col = u.pn * 256 + c, b = row >> 12;
        const size_t o = (size_t)row * 1024 + col;
        const float* g = mods + b * 6144 + 2 * 1024 + col;
        const f32x4 x0 = *(const f32x4*)(x + o), x1 = *(const f32x4*)(x + o + 4), g0 = *(const f32x4*)g, g1v = *(const f32x4*)(g + 4);
        *(f32x4*)(t1 + o) = x0 * ALPHA + g0 * v0; *(f32x4*)(t1 + o + 4) = x1 * ALPHA + g1v * v1;
    }
};
struct EpiMoeUp {
    bf16* H;
    __device__ __forceinline__ void chunk(const Unit& u, int r, int c, f32x4 v0, f32x4 v1) const {
        const size_t row = (size_t)u.pm * 256 + r; const int f = ((u.pn * 256 + c) >> 3) * 4;
        u32x2 w; w.x = pk2(siluf_(v0[0]) * v1[0], siluf_(v0[1]) * v1[1]); w.y = pk2(siluf_(v0[2]) * v1[2], siluf_(v0[3]) * v1[3]);
        *(u32x2*)(H + row * 512 + f) = w;
    }
};
struct EpiMoeDown {
    const unsigned* cnt; const unsigned* lst; const float* lstw; bf16* Y;
    __device__ __forceinline__ void chunk(const Unit& u, int r, int c, f32x4 v0, f32x4 v1) const {
        const unsigned pos = (unsigned)(u.mt * 256 + r);
        if (pos < cnt[u.e * CNT_STRIDE]) {
            const unsigned ent = lst[(size_t)u.e * NTOK + pos]; const float w = lstw[(size_t)u.e * NTOK + pos];
            bf16* dst = Y + ((size_t)(ent & 1u) * NTOK + (ent >> 1)) * 1024 + u.pn * 256 + c;
            *(u32x4*)dst = pack8(v0 * w, v1 * w);
        }
    }
};
struct MoeOrder {
    static constexpr bool GATHER = true;
    const LAS int* ts; const unsigned* cnt; const unsigned* lst; int G, c, mode;
    __device__ __forceinline__ bool next(int i, Unit& u) const {
        const int L = i * G + c, ntile = ts[32]; if (L >= 4 * ntile) return false;
        const int T = L >> 2; int e = 0;
        for (int j = 1; j < 32; ++j) e += (ts[j] <= T) ? 1 : 0;
        u.pm = T; u.pn = L & 3; u.e = e; u.mt = T - ts[e]; return true;
    }
    __device__ __forceinline__ size_t a_base(const Unit& u) const { return mode == 0 ? (size_t)0 : (size_t)u.pm * 256 * 1024; }
    __device__ __forceinline__ unsigned a_lane(const Unit& u, int r) const {
        if (mode == 0) { unsigned pos = (unsigned)(u.mt * 256 + r); if (pos >= cnt[u.e * CNT_STRIDE]) pos = 0; return (lst[(size_t)u.e * NTOK + pos] >> 1) * 2048u; }
        return (unsigned)r * 1024u;
    }
    __device__ __forceinline__ size_t b_off(const Unit& u) const {
        return mode == 0 ? ((size_t)u.e * 1024 + (size_t)u.pn * 256) * 1024 * 2 : ((size_t)u.e * 1024 + (size_t)u.pn * 256) * 512 * 2;
    }
};

struct MapWin { __device__ __forceinline__ int operator()(int n) const { return n < 3072 ? n : (n < 3088 ? C_LR + (n - 3072) : n - 16); } };
struct MapId { __device__ __forceinline__ int operator()(int n) const { return n; } };
struct MapGate { __device__ __forceinline__ int operator()(int f) const { return (f >> 2) * 8 + (f & 3); } };
struct MapUp { __device__ __forceinline__ int operator()(int f) const { return (f >> 2) * 8 + 4 + (f & 3); } };
template <class RowMap>
__device__ __forceinline__ void transpose_item(const float* W, int K, int N, bf16* WT, LAS float* scr, int item, int lane, RowMap rm) {
    const int nblk = (N + 31) / 32, kb = item / nblk, nb = item % nblk, k0 = 64 * kb, n0 = 32 * nb;
    const int kr = lane >> 3, nq = (lane & 7) * 4; const bool ok = (n0 + nq) < N;
    f32x4 v[8];
#pragma unroll
    for (int i = 0; i < 8; ++i) v[i] = ok ? *(const f32x4*)(W + (size_t)(k0 + 8 * i + kr) * N + n0 + nq) : (f32x4){0.f, 0.f, 0.f, 0.f};
#pragma unroll
    for (int i = 0; i < 8; ++i) { LAS float* d = scr + (8 * i + kr) * 33 + nq; d[0] = v[i][0]; d[1] = v[i][1]; d[2] = v[i][2]; d[3] = v[i][3]; }
    LDS_WAIT(); asm volatile("" ::: "memory");
    const int c = lane & 7;
#pragma unroll
    for (int j = 0; j < 4; ++j) { const int n = (lane >> 3) + 8 * j; const LAS float* s = scr + (8 * c) * 33 + n;
        u32x4 o; o.x = pk2(s[0 * 33], s[1 * 33]); o.y = pk2(s[2 * 33], s[3 * 33]); o.z = pk2(s[4 * 33], s[5 * 33]); o.w = pk2(s[6 * 33], s[7 * 33]);
        if (n0 + n < N) *(u32x4*)(WT + (size_t)rm(n0 + n) * K + k0 + 8 * c) = o; }
    LDS_WAIT(); asm volatile("" ::: "memory");
}
__device__ __forceinline__ int t5_bucket(int dist) {
    if (dist < 16) return dist;
    int large = 16 + (int)(log((double)dist / 16.0) / log(128.0) * 16.0);
    return large < 31 ? large : 31;
}
__device__ __forceinline__ void p0_phase(Frame& F, const Args& args) {
    LAS float* scr = (LAS float*)(F.lds + F.wave * 16384);
    LAS f32x4* sc = (LAS f32x4*)(F.lds + 131072);
    const float* c = args.in[1];
    for (int k = F.tid; k < 1024; k += NTHR) sc[k] = (f32x4){siluf_(c[k]), siluf_(c[1024 + k]), siluf_(c[2048 + k]), siluf_(c[3072 + k])};
    __syncthreads();
    const int gw = F.vcu * NWAVES + F.wave, NGW = F.G * NWAVES, lane = F.lane;
    float* mods = (float*)(F.ws + WS_MODS);
#pragma unroll 1
    for (int it = gw; it < 384; it += NGW) {
        const int col = it * 16 + (lane & 15), kq = lane >> 4; const float* w = args.in[3] + col;
        float a0 = 0.f, a1 = 0.f, a2 = 0.f, a3 = 0.f;
#pragma unroll 32
        for (int k = kq; k < 1024; k += 4) { const float wv = w[(size_t)k * 6144]; const f32x4 s = sc[k]; a0 += s.x * wv; a1 += s.y * wv; a2 += s.z * wv; a3 += s.w * wv; }
        a0 += __shfl_xor(a0, 16); a0 += __shfl_xor(a0, 32); a1 += __shfl_xor(a1, 16); a1 += __shfl_xor(a1, 32);
        a2 += __shfl_xor(a2, 16); a2 += __shfl_xor(a2, 32); a3 += __shfl_xor(a3, 16); a3 += __shfl_xor(a3, 32);
        if (lane < 16) { const float bb = args.in[4][col]; mods[col] = a0 + bb; mods[6144 + col] = a1 + bb; mods[2 * 6144 + col] = a2 + bb; mods[3 * 6144 + col] = a3 + bb; }
    }
    if (gw == NGW - 1) {
        float* bt = (float*)(F.ws + WS_BTAB);
        for (int i = lane; i < 24 * 129; i += 64) { const int h = i / 129, m = i % 129, dil = (h < 8) ? 1 : (h < 16 ? 4 : 16); bt[h * 132 + m] = args.in[2][t5_bucket(m * dil) * 24 + h]; }
    }
    constexpr int I_IN = 16 * 305, I_PG = 16 * 32, I_PA = 8 * 32, I_OUT = 16 * 32, I_PAD = 240, I_WR = 48;
    constexpr int NIT = I_IN + I_PG + I_PA + I_OUT + I_PAD + I_WR;
#pragma unroll 1
    for (int it = gw; it < NIT; it += NGW) {
        int r = it;
        if (r < I_IN) { transpose_item(args.in[5], 1024, INCOLS, (bf16*)(F.ws + WS_WIN), scr, r, lane, MapWin()); continue; } r -= I_IN;
        if (r < I_PG) { transpose_item(args.in[9], 1024, 1024, (bf16*)(F.ws + WS_WPG), scr, r, lane, MapId()); continue; } r -= I_PG;
        if (r < I_PA) { transpose_item(args.in[10], 512, 1024, (bf16*)(F.ws + WS_WPA), scr, r, lane, MapId()); continue; } r -= I_PA;
        if (r < I_OUT) { transpose_item(args.in[11], 1024, 1024, (bf16*)(F.ws + WS_WOUT), scr, r, lane, MapId()); continue; } r -= I_OUT;
        if (r < I_PAD) { u32x4* z = (u32x4*)((bf16*)(F.ws + WS_WIN) + (size_t)(INCOLS + r) * 1024); z[lane] = (u32x4){0u, 0u, 0u, 0u}; z[64 + lane] = (u32x4){0u, 0u, 0u, 0u}; continue; } r -= I_PAD;
        {
            bf16* hi_ = (bf16*)(F.ws + WS_WRT) + (size_t)r * 1024; bf16* lo_ = hi_ + 48 * 1024;
            for (int k = lane; k < 1024; k += 64) { const float v = (r < 4) ? args.in[14][k * 4 + r] : (r < 36 ? args.in[16][k * 32 + r - 4] : 0.f);
                const bf16 h = f2bf(v); hi_[k] = h; lo_[k] = f2bf(v - bf2f(h)); }
        }
    }
}
__device__ __forceinline__ void convert_experts(Frame& F, const Args& args) {
    LAS float* scr = (LAS float*)(F.lds + F.wave * 16384);
    const int gw = F.vcu * NWAVES + F.wave, NGW = F.G * NWAVES, lane = F.lane;
    bf16* wgu = (bf16*)(F.ws + WS_WGU); bf16* wdn = (bf16*)(F.ws + WS_WDN);
#pragma unroll 1
    for (int it = gw; it < 3 * 8192; it += NGW) {
        const int kind = it >> 13, r = it & 8191, e = r >> 8, sub = r & 255;
        if (kind == 0) transpose_item(args.in[18] + (size_t)e * 1024 * 512, 1024, 512, wgu + (size_t)e * 1024 * 1024, scr, sub, lane, MapGate());
        else if (kind == 1) transpose_item(args.in[19] + (size_t)e * 1024 * 512, 1024, 512, wgu + (size_t)e * 1024 * 1024, scr, sub, lane, MapUp());
        else transpose_item(args.in[20] + (size_t)e * 512 * 1024, 512, 1024, wdn + (size_t)e * 1024 * 512, scr, sub, lane, MapId());
    }
}
__device__ __forceinline__ void p0b_phase(Frame& F, const Args& args) {
    const int gw = F.vcu * NWAVES + F.wave, NGW = F.G * NWAVES, lane = F.lane;
    const float* mods = (const float*)(F.ws + WS_MODS); bf16* U = (bf16*)(F.ws + WS_U);
#pragma unroll 1
    for (int m = gw; m < NTOK; m += NGW) {
        const int b = m >> 12; const f32x4* xr = (const f32x4*)(args.in[0] + (size_t)m * 1024) + lane;
        const f32x4* sh = (const f32x4*)(mods + b * 6144) + lane; const f32x4* sc = (const f32x4*)(mods + b * 6144 + 1024) + lane;
        u32x2* o = (u32x2*)(U + (size_t)m * 1024) + lane;
#pragma unroll
        for (int j = 0; j < 4; ++j) { const f32x4 v = xr[64 * j] * (sc[64 * j] + 1.f) + sh[64 * j]; u32x2 w; w.x = pk2(v[0], v[1]); w.y = pk2(v[2], v[3]); o[64 * j] = w; }
    }
}

__device__ __forceinline__ s16x4 tr_read(const LAS unsigned char* p) {
    typedef short v4i16_t __attribute__((ext_vector_type(4)));
    return __builtin_bit_cast(s16x4, __builtin_amdgcn_ds_read_tr16_b64_v4i16((LAS v4i16_t*)p));
}
__device__ __forceinline__ void attn_phase(Frame& F) {
    const int tid = F.tid, lane = F.lane, wid = F.wave, half = wid >> 2, w4 = wid & 3, l31 = lane & 31, hi = lane >> 5;
    LAS unsigned char* Kl = F.lds + half * 36864;
    LAS unsigned char* Vl = F.lds + 73728 + half * 36864;
    LAS float* bl = (LAS float*)(F.lds + 147456) + half * 192;
    bf16* QD = (bf16*)(F.ws + WS_QD); const bf16* KD = (const bf16*)(F.ws + WS_KD); const bf16* VD = (const bf16*)(F.ws + WS_VD);
    float* LSE = (float*)(F.ws + WS_LSE); const float* BT = (const float*)(F.ws + WS_BTAB);
#pragma unroll 1
    for (int it = 0;; ++it) {
        const int L = it * F.G + F.vcu; if (L >= 1536) break;
        const int g = L >> 9, wq = L & 511, b = wq >> 7, w2 = wq & 127, hp = w2 >> 5, w3 = w2 & 31;
        const int dsh = 2 * g, dil = 1 << dsh, nblk = 32 >> dsh, r = w3 / nblk, nb = w3 % nblk;
        const int head = 2 * hp + half, colb = g * 512 + head * 64;
        __syncthreads();
        {
            const int t = tid & 255, ch = t & 7;
#pragma unroll
            for (int p = 0; p < 8; ++p) {
                const int row = p * 32 + (t >> 3), lidx = nb * 128 - 128 + row;
                u32x4 kv = (u32x4){0u, 0u, 0u, 0u}, vv = kv;
                if (lidx >= 0) { const size_t o = (size_t)(b * SEQ + lidx * dil + r) * 1536 + colb + ch * 8; kv = *(const u32x4*)(KD + o); vv = *(const u32x4*)(VD + o); }
                *(LAS u32x4*)(Kl + row * 144 + ch * 16) = kv; *(LAS u32x4*)(Vl + row * 144 + ch * 16) = vv;
            }
            if (t < 192) bl[t] = (t >= 32 && t <= 160) ? BT[(g * 8 + head) * 132 + t - 32] : 0.f;
        }
        const int qi = 32 * w4 + l31; const size_t qtok = (size_t)(b * SEQ + (nb * 128 + qi) * dil + r);
        bf16x8 qf[4];
#pragma unroll
        for (int kk = 0; kk < 4; ++kk) qf[kk] = *(const bf16x8*)(QD + qtok * 1536 + colb + kk * 16 + hi * 8);
        __syncthreads();
        f32x16 sa[5]; float mx = -INFINITY;
        const int mb = l31 + 128 - 4 * hi;
        const LAS float* blq = bl + (mb - 123);
        const unsigned mlim = (nb > 0) ? 128u : (unsigned)(qi < 128 ? qi : 128);
#pragma unroll
        for (int t = 0; t < 5; ++t) {
            const int kt = w4 + t; const bool act = (nb > 0) || (kt >= 4);
            f32x16 a = {0.f, 0.f, 0.f, 0.f, 0.f, 0.f, 0.f, 0.f, 0.f, 0.f, 0.f, 0.f, 0.f, 0.f, 0.f, 0.f};
            if (act) {
                const LAS unsigned char* kp = Kl + (32 * kt + l31) * 144 + hi * 16;
#pragma unroll
                for (int kk = 0; kk < 4; ++kk) { const bf16x8 kf = *(const LAS bf16x8*)(kp + kk * 32); a = __builtin_amdgcn_mfma_f32_32x32x16_bf16(kf, qf[kk], a, 0, 0, 0); }
            }
#pragma unroll
            for (int rr = 0; rr < 16; ++rr) {
                const int cc = 32 * t + (rr & 3) + 8 * (rr >> 2);
                const unsigned m = (unsigned)(mb - cc);
                float s = a[rr] + blq[155 - cc];
                s = (m <= mlim) ? s : -INFINITY;
                a[rr] = s; mx = fmaxf(mx, s);
            }
            sa[t] = a;
        }
        mx = fmaxf(mx, __shfl_xor(mx, 32));
        float sum = 0.f;
#pragma unroll
        for (int t = 0; t < 5; ++t)
#pragma unroll
            for (int rr = 0; rr < 16; ++rr) { const float p = __expf(sa[t][rr] - mx); sa[t][rr] = p; sum += p; }
        sum += __shfl_xor(sum, 32);
        f32x16 o0 = {0.f, 0.f, 0.f, 0.f, 0.f, 0.f, 0.f, 0.f, 0.f, 0.f, 0.f, 0.f, 0.f, 0.f, 0.f, 0.f}, o1 = o0;
        const int i16 = lane & 15, g2 = (lane >> 4) & 1;
        const LAS unsigned char* vbase = Vl + (4 * hi + (i16 >> 2)) * 144 + (16 * g2 + 4 * (i16 & 3)) * 2;
#pragma unroll
        for (int t = 0; t < 5; ++t) {
            const int kt = w4 + t; const bool act = (nb > 0) || (kt >= 4);
            if (act) {
#pragma unroll
                for (int s2 = 0; s2 < 2; ++s2) {
                    u32x4 pw; pw.x = pk2(sa[t][8 * s2 + 0], sa[t][8 * s2 + 1]); pw.y = pk2(sa[t][8 * s2 + 2], sa[t][8 * s2 + 3]); pw.z = pk2(sa[t][8 * s2 + 4], sa[t][8 * s2 + 5]); pw.w = pk2(sa[t][8 * s2 + 6], sa[t][8 * s2 + 7]);
                    const bf16x8 pf = __builtin_bit_cast(bf16x8, pw);
                    const LAS unsigned char* vp = vbase + (32 * kt + 16 * s2) * 144;
                    const s16x4 a0 = tr_read(vp), a1 = tr_read(vp + 8 * 144), c0 = tr_read(vp + 64), c1 = tr_read(vp + 8 * 144 + 64);
                    const bf16x8 vf0 = (bf16x8){a0[0], a0[1], a0[2], a0[3], a1[0], a1[1], a1[2], a1[3]};
                    const bf16x8 vf1 = (bf16x8){c0[0], c0[1], c0[2], c0[3], c1[0], c1[1], c1[2], c1[3]};
                    o0 = __builtin_amdgcn_mfma_f32_32x32x16_bf16(vf0, pf, o0, 0, 0, 0);
                    o1 = __builtin_amdgcn_mfma_f32_32x32x16_bf16(vf1, pf, o1, 0, 0, 0);
                }
            }
        }
        const float inv = 1.f / sum;
        bf16* orow = QD + qtok * 1536 + colb;
#pragma unroll
        for (int a4 = 0; a4 < 4; ++a4) {
            u32x2 w0, w1;
            w0.x = pk2(o0[4 * a4] * inv, o0[4 * a4 + 1] * inv); w0.y = pk2(o0[4 * a4 + 2] * inv, o0[4 * a4 + 3] * inv);
            w1.x = pk2(o1[4 * a4] * inv, o1[4 * a4 + 1] * inv); w1.y = pk2(o1[4 * a4 + 2] * inv, o1[4 * a4 + 3] * inv);
            *(u32x2*)(orow + 8 * a4 + 4 * hi) = w0; *(u32x2*)(orow + 32 + 8 * a4 + 4 * hi) = w1;
        }
        if (hi == 0) LSE[qtok * 24 + g * 8 + head] = mx + __logf(sum);
    }
    __syncthreads();
}
__device__ __forceinline__ void combine_phase(Frame& F) {
    const int gw = F.vcu * NWAVES + F.wave, NGW = F.G * NWAVES, lane = F.lane, hh = lane >> 3, ch = lane & 7;
    const bf16* OG = (const bf16*)(F.ws + WS_QD); const float* LSE = (const float*)(F.ws + WS_LSE); bf16* YA = (bf16*)(F.ws + WS_YATT);
#pragma unroll 1
    for (int m = gw; m < NTOK; m += NGW) {
        const float l0 = LSE[(size_t)m * 24 + hh], l1 = LSE[(size_t)m * 24 + 8 + hh], l2 = LSE[(size_t)m * 24 + 16 + hh];
        const float mm = fmaxf(l0, fmaxf(l1, l2)); float e0 = __expf(l0 - mm), e1 = __expf(l1 - mm), e2 = __expf(l2 - mm); const float is = 1.f / (e0 + e1 + e2);
        e0 *= is; e1 *= is; e2 *= is;
        const bf16* o = OG + (size_t)m * 1536 + hh * 64 + ch * 8;
        f32x4 a0, a1, b0, b1, c0, c1; unpack8(*(const u32x4*)o, a0, a1); unpack8(*(const u32x4*)(o + 512), b0, b1); unpack8(*(const u32x4*)(o + 1024), c0, c1);
        *(u32x4*)(YA + (size_t)m * 512 + hh * 64 + ch * 8) = pack8(a0 * e0 + b0 * e1 + c0 * e2, a1 * e0 + b1 * e1 + c1 * e2);
    }
}

constexpr int GA_LB = 0, GA_QT = 33792, GA_KT = 51200, GA_KH = 68608, GA_VT = 87040, GA_AT = 123904, GA_LR = 133120, GA_WG = 137216, GA_BG = 145408, GA_QS = 145920;
__device__ __forceinline__ float log_sigmoid_(float x) { return fminf(x, 0.f) - __logf(1.f + __expf(-fabsf(x))); }
__device__ __forceinline__ void gla_a_phase(Frame& F, const Args& args) {
    const int tid = F.tid, lane = F.lane, wid = F.wave, l31 = lane & 31, hi = lane >> 5;
    LAS unsigned char* lds = F.lds;
    LAS float* LB = (LAS float*)(lds + GA_LB); LAS float* LRs = (LAS float*)(lds + GA_LR); LAS float* QS = (LAS float*)(lds + GA_QS);
    bf16* QA = (bf16*)(F.ws + WS_QA); const bf16* KA = (const bf16*)(F.ws + WS_KA); bf16* VA = (bf16*)(F.ws + WS_VA);
    const float* LR = (const float*)(F.ws + WS_LR); bf16* DS = (bf16*)(F.ws + WS_DS); float* DEC = (float*)(F.ws + WS_DECAY);
    if (F.vcu >= 1024) return;
    const int h0 = (F.vcu >> 6) & 3, kcol = tid & 127, tq = tid >> 7;
    float wg[16];
#pragma unroll
    for (int j = 0; j < 16; ++j) wg[j] = args.in[6][j * 512 + h0 * 128 + kcol];
    const float bg = args.in[7][h0 * 128 + kcol];
    u32x4 pq[2], pk[2], pv[4]; f32x4 plr = {0.f, 0.f, 0.f, 0.f};
#define GLA_PREFETCH(UU) do { const int bh_ = (UU) >> 6, c_ = (UU) & 63; const size_t tk_ = (size_t)(bh_ >> 2) * SEQ + c_ * 64 + lane; const int h_ = bh_ & 3; \
        _Pragma("unroll") for (int p = 0; p < 2; ++p) { pq[p] = *(const u32x4*)(QA + tk_ * 512 + h_ * 128 + (wid * 2 + p) * 8); pk[p] = *(const u32x4*)(KA + tk_ * 512 + h_ * 128 + (wid * 2 + p) * 8); } \
        _Pragma("unroll") for (int p = 0; p < 4; ++p) pv[p] = *(const u32x4*)(VA + tk_ * 1024 + h_ * 256 + (wid * 4 + p) * 8); \
        if (tid < 256) plr = *(const f32x4*)(LR + ((size_t)(bh_ >> 2) * SEQ + c_ * 64) * 16 + tid * 4); } while (0)
    GLA_PREFETCH(F.vcu);
#pragma unroll 1
    for (int it = 0;; ++it) {
        const int U = it * F.G + F.vcu; if (U >= 1024) break;
        const int bh = U >> 6, c = U & 63, b = bh >> 2, h = bh & 3; const size_t tok0 = (size_t)b * SEQ + c * 64;
        __syncthreads();
        if (tid < 256) *(LAS f32x4*)(LRs + tid * 4) = plr;
        __syncthreads();
        {
            const int k = kcol; float cs = 0.f;
#pragma unroll 4
            for (int tt = 0; tt < 16; ++tt) { const int t = tq * 16 + tt; float lg = bg;
#pragma unroll
                for (int j4 = 0; j4 < 4; ++j4) { const f32x4 l4 = *(const LAS f32x4*)(LRs + t * 16 + j4 * 4); lg += l4[0] * wg[4 * j4] + l4[1] * wg[4 * j4 + 1] + l4[2] * wg[4 * j4 + 2] + l4[3] * wg[4 * j4 + 3]; }
                cs += log_sigmoid_(lg) * (1.f / 16.f); LB[t * 132 + k] = cs; }
            QS[tq * 128 + k] = cs;
            __syncthreads();
            float off = 0.f;
#pragma unroll
            for (int q = 0; q < 3; ++q) off += (q < tq) ? QS[q * 128 + k] : 0.f;
            if (tq > 0) {
#pragma unroll 4
                for (int tt = 0; tt < 16; ++tt) LB[(tq * 16 + tt) * 132 + k] += off;
            }
        }
        __syncthreads();
        {
            const int t = lane; const size_t tok = tok0 + t;
#pragma unroll
            for (int p = 0; p < 2; ++p) {
                const int kc = wid * 2 + p;
                f32x4 q0, q1, k0, k1; unpack8(pq[p], q0, q1); unpack8(pk[p], k0, k1);
                const f32x4 b0 = *(const LAS f32x4*)(LB + t * 132 + kc * 8), b1 = *(const LAS f32x4*)(LB + t * 132 + kc * 8 + 4);
                const f32x4 e0 = *(const LAS f32x4*)(LB + 63 * 132 + kc * 8), e1 = *(const LAS f32x4*)(LB + 63 * 132 + kc * 8 + 4);
                f32x4 qt0, qt1, kt0, kt1, kh0, kh1;
#pragma unroll
                for (int j = 0; j < 4; ++j) {
                    qt0[j] = q0[j] * __expf(b0[j]); qt1[j] = q1[j] * __expf(b1[j]);
                    kt0[j] = k0[j] * __expf(-b0[j]); kt1[j] = k1[j] * __expf(-b1[j]);
                    kh0[j] = k0[j] * __expf(e0[j] - b0[j]); kh1[j] = k1[j] * __expf(e1[j] - b1[j]);
                }
                const u32x4 qw = pack8(qt0, qt1);
                *(LAS u32x4*)(lds + GA_QT + t * 272 + kc * 16) = qw; *(u32x4*)(QA + tok * 512 + h * 128 + kc * 8) = qw;
                *(LAS u32x4*)(lds + GA_KT + t * 272 + kc * 16) = pack8(kt0, kt1);
#pragma unroll
                for (int j = 0; j < 4; ++j) { *(LAS bf16*)(lds + GA_KH + (kc * 8 + j) * 144 + t * 2) = f2bf(kh0[j]); *(LAS bf16*)(lds + GA_KH + (kc * 8 + 4 + j) * 144 + t * 2) = f2bf(kh1[j]); }
            }
#pragma unroll
            for (int p = 0; p < 4; ++p) {
                const int vc = wid * 4 + p; const u32x4 vv = pv[p];
                const unsigned w[4] = {vv.x, vv.y, vv.z, vv.w};
#pragma unroll
                for (int j = 0; j < 4; ++j) { *(LAS bf16*)(lds + GA_VT + (vc * 8 + 2 * j) * 144 + t * 2) = (bf16)(w[j] & 0xffffu); *(LAS bf16*)(lds + GA_VT + (vc * 8 + 2 * j + 1) * 144 + t * 2) = (bf16)(w[j] >> 16); }
            }
            if (tid < 128) DEC[(size_t)U * 128 + tid] = __expf(LB[63 * 132 + tid]);
        }
        { const int Un = U + F.G; if (Un < 1024) GLA_PREFETCH(Un); }
        __syncthreads();
        if (wid < 4) {
            const int mt = wid >> 1, nt = wid & 1;
            f32x16 a = {0.f, 0.f, 0.f, 0.f, 0.f, 0.f, 0.f, 0.f, 0.f, 0.f, 0.f, 0.f, 0.f, 0.f, 0.f, 0.f};
#pragma unroll
            for (int kk = 0; kk < 8; ++kk) {
                const bf16x8 qf = *(const LAS bf16x8*)(lds + GA_QT + (32 * mt + l31) * 272 + kk * 32 + hi * 16);
                const bf16x8 kf = *(const LAS bf16x8*)(lds + GA_KT + (32 * nt + l31) * 272 + kk * 32 + hi * 16);
                a = __builtin_amdgcn_mfma_f32_32x32x16_bf16(qf, kf, a, 0, 0, 0);
            }
            const int s = 32 * nt + l31;
#pragma unroll
            for (int rr = 0; rr < 16; ++rr) { const int t = 32 * mt + crow(rr, hi); *(LAS bf16*)(lds + GA_AT + t * 144 + s * 2) = f2bf(t >= s ? a[rr] : 0.f); }
        }
        __syncthreads();
        {
            f32x16 a0 = {0.f, 0.f, 0.f, 0.f, 0.f, 0.f, 0.f, 0.f, 0.f, 0.f, 0.f, 0.f, 0.f, 0.f, 0.f, 0.f}, a1 = a0;
#pragma unroll
            for (int ks = 0; ks < 4; ++ks) {
                const bf16x8 vf = *(const LAS bf16x8*)(lds + GA_VT + (32 * wid + l31) * 144 + ks * 32 + hi * 16);
                const bf16x8 t0 = *(const LAS bf16x8*)(lds + GA_AT + l31 * 144 + ks * 32 + hi * 16);
                const bf16x8 t1 = *(const LAS bf16x8*)(lds + GA_AT + (32 + l31) * 144 + ks * 32 + hi * 16);
                a0 = __builtin_amdgcn_mfma_f32_32x32x16_bf16(vf, t0, a0, 0, 0, 0);
                a1 = __builtin_amdgcn_mfma_f32_32x32x16_bf16(vf, t1, a1, 0, 0, 0);
            }
            bf16* o0 = VA + (tok0 + l31) * 1024 + h * 256 + 32 * wid + 4 * hi; bf16* o1 = o0 + 32 * 1024;
#pragma unroll
            for (int a4 = 0; a4 < 4; ++a4) {
                u32x2 w0, w1; w0.x = pk2(a0[4 * a4], a0[4 * a4 + 1]); w0.y = pk2(a0[4 * a4 + 2], a0[4 * a4 + 3]); w1.x = pk2(a1[4 * a4], a1[4 * a4 + 1]); w1.y = pk2(a1[4 * a4 + 2], a1[4 * a4 + 3]);
                *(u32x2*)(o0 + 8 * a4) = w0; *(u32x2*)(o1 + 8 * a4) = w1;
            }
        }
        {
            f32x16 a[4];
#pragma unroll
            for (int mt = 0; mt < 4; ++mt) a[mt] = (f32x16){0.f, 0.f, 0.f, 0.f, 0.f, 0.f, 0.f, 0.f, 0.f, 0.f, 0.f, 0.f, 0.f, 0.f, 0.f, 0.f};
#pragma unroll
            for (int ks = 0; ks < 4; ++ks) {
                const bf16x8 vf = *(const LAS bf16x8*)(lds + GA_VT + (32 * wid + l31) * 144 + ks * 32 + hi * 16);
#pragma unroll
                for (int mt = 0; mt < 4; ++mt) { const bf16x8 kf = *(const LAS bf16x8*)(lds + GA_KH + (32 * mt + l31) * 144 + ks * 32 + hi * 16); a[mt] = __builtin_amdgcn_mfma_f32_32x32x16_bf16(kf, vf, a[mt], 0, 0, 0); }
            }
            bf16* d = DS + (size_t)U * 32768 + (size_t)(32 * wid + l31) * 128 + 4 * hi;
#pragma unroll
            for (int mt = 0; mt < 4; ++mt)
#pragma unroll
                for (int a4 = 0; a4 < 4; ++a4) { u32x2 w; w.x = pk2(a[mt][4 * a4], a[mt][4 * a4 + 1]); w.y = pk2(a[mt][4 * a4 + 2], a[mt][4 * a4 + 3]); *(u32x2*)(d + 32 * mt + 8 * a4) = w; }
        }
    }
#undef GLA_PREFETCH
    __syncthreads();
}
__device__ __forceinline__ void gla_scan_phase(Frame& F) {
    bf16* DS = (bf16*)(F.ws + WS_DS); const float* DEC = (const float*)(F.ws + WS_DECAY);
#pragma unroll 1
    for (int e4 = F.vcu * NTHR + F.tid; e4 < 16 * 8192; e4 += F.G * NTHR) {
        const int bh = e4 >> 13, rem = e4 & 8191; const size_t eo = (size_t)(rem >> 5) * 128 + (rem & 31) * 4;
        f32x4 s = {0.f, 0.f, 0.f, 0.f};
#pragma unroll 8
        for (int c = 0; c < 64; ++c) {
            const size_t U = (size_t)bh * 64 + c; u32x2* p = (u32x2*)(DS + U * 32768 + eo);
            const u32x2 w = *p; const f32x4 dc = *(const f32x4*)(DEC + U * 128 + (rem & 31) * 4);
            u32x2 o; o.x = pk2(s[0], s[1]); o.y = pk2(s[2], s[3]); *p = o;
            s[0] = s[0] * dc[0] + bflo(w.x); s[1] = s[1] * dc[1] + bfhi(w.x); s[2] = s[2] * dc[2] + bflo(w.y); s[3] = s[3] * dc[3] + bfhi(w.y);
        }
    }
}
__device__ __forceinline__ void gla_c_phase(Frame& F, const Args& args) {
    const int tid = F.tid, lane = F.lane, wid = F.wave, l31 = lane & 31, hi = lane >> 5;
    LAS unsigned char* lds = F.lds; LAS float* SS = (LAS float*)(lds + 20480);
    const bf16* QA = (const bf16*)(F.ws + WS_QA); const bf16* OI = (const bf16*)(F.ws + WS_VA); const bf16* RA = (const bf16*)(F.ws + WS_RA);
    const bf16* DS = (const bf16*)(F.ws + WS_DS); bf16* YG = (bf16*)(F.ws + WS_YGLA);
#pragma unroll 1
    for (int it = 0;; ++it) {
        const int U = it * F.G + F.vcu; if (U >= 1024) break;
        const int bh = U >> 6, c = U & 63, b = bh >> 2, h = bh & 3; const size_t tok0 = (size_t)b * SEQ + c * 64;
        __syncthreads();
#pragma unroll
        for (int p = 0; p < 2; ++p) { const int ch = tid + p * NTHR, t = ch >> 4, kc = ch & 15; *(LAS u32x4*)(lds + t * 272 + kc * 16) = *(const u32x4*)(QA + (tok0 + t) * 512 + h * 128 + kc * 8); }
        __syncthreads();
        f32x16 a0 = {0.f, 0.f, 0.f, 0.f, 0.f, 0.f, 0.f, 0.f, 0.f, 0.f, 0.f, 0.f, 0.f, 0.f, 0.f, 0.f}, a1 = a0;
        const bf16* srow = DS + (size_t)U * 32768 + (size_t)(32 * wid + l31) * 128 + hi * 8;
#pragma unroll
        for (int kk = 0; kk < 8; ++kk) {
            const bf16x8 sf = *(const bf16x8*)(srow + kk * 16);
            const bf16x8 q0 = *(const LAS bf16x8*)(lds + l31 * 272 + kk * 32 + hi * 16);
            const bf16x8 q1 = *(const LAS bf16x8*)(lds + (32 + l31) * 272 + kk * 32 + hi * 16);
            a0 = __builtin_amdgcn_mfma_f32_32x32x16_bf16(sf, q0, a0, 0, 0, 0);
            a1 = __builtin_amdgcn_mfma_f32_32x32x16_bf16(sf, q1, a1, 0, 0, 0);
        }
        const size_t e0 = (tok0 + l31) * 1024 + h * 256 + 32 * wid + 4 * hi, e1 = e0 + 32 * 1024;
        float q0s = 0.f, q1s = 0.f;
#pragma unroll
        for (int a4 = 0; a4 < 4; ++a4) {
            const u32x2 w0 = *(const u32x2*)(OI + e0 + 8 * a4), w1 = *(const u32x2*)(OI + e1 + 8 * a4);
            a0[4 * a4] += bflo(w0.x); a0[4 * a4 + 1] += bfhi(w0.x); a0[4 * a4 + 2] += bflo(w0.y); a0[4 * a4 + 3] += bfhi(w0.y);
            a1[4 * a4] += bflo(w1.x); a1[4 * a4 + 1] += bfhi(w1.x); a1[4 * a4 + 2] += bflo(w1.y); a1[4 * a4 + 3] += bfhi(w1.y);
#pragma unroll
            for (int j = 0; j < 4; ++j) { q0s += a0[4 * a4 + j] * a0[4 * a4 + j]; q1s += a1[4 * a4 + j] * a1[4 * a4 + j]; }
        }
        q0s += __shfl_xor(q0s, 32); q1s += __shfl_xor(q1s, 32);
        if (hi == 0) { SS[wid * 64 + l31] = q0s; SS[wid * 64 + 32 + l31] = q1s; }
        __syncthreads();
        float t0 = 0.f, t1 = 0.f;
#pragma unroll
        for (int w = 0; w < 8; ++w) { t0 += SS[w * 64 + l31]; t1 += SS[w * 64 + 32 + l31]; }
        const float r0 = rsqrtf(t0 * (1.f / 256.f) + LN_EPS), r1 = rsqrtf(t1 * (1.f / 256.f) + LN_EPS);
        const float* ng = args.in[8] + h * 256 + 32 * wid + 4 * hi;
#pragma unroll
        for (int a4 = 0; a4 < 4; ++a4) {
            const f32x4 g4 = *(const f32x4*)(ng + 8 * a4);
            const u32x2 s0 = *(const u32x2*)(RA + e0 + 8 * a4), s1 = *(const u32x2*)(RA + e1 + 8 * a4);
            u32x2 w0, w1;
            w0.x = pk2(a0[4 * a4] * r0 * g4[0] * bflo(s0.x), a0[4 * a4 + 1] * r0 * g4[1] * bfhi(s0.x)); w0.y = pk2(a0[4 * a4 + 2] * r0 * g4[2] * bflo(s0.y), a0[4 * a4 + 3] * r0 * g4[3] * bfhi(s0.y));
            w1.x = pk2(a1[4 * a4] * r1 * g4[0] * bflo(s1.x), a1[4 * a4 + 1] * r1 * g4[1] * bfhi(s1.x)); w1.y = pk2(a1[4 * a4 + 2] * r1 * g4[2] * bflo(s1.y), a1[4 * a4 + 3] * r1 * g4[3] * bfhi(s1.y));
            *(u32x2*)(YG + e0 + 8 * a4) = w0; *(u32x2*)(YG + e1 + 8 * a4) = w1;
        }
    }
    __syncthreads();
}

__device__ __forceinline__ void ln1_router_phase(Frame& F, const Args& args) {
    const int tid = F.tid, lane = F.lane, wid = F.wave, tok = lane & 15, kg = lane >> 4;
    LAS float* LGT = (LAS float*)F.lds + wid * 1024;
    LAS unsigned* lcnt = (LAS unsigned*)(F.lds + 65536); LAS unsigned* lbase = lcnt + 32; LAS unsigned* rec = lcnt + 64;
    if (tid < 32) lcnt[tid] = 0u;
    if (tid < 64) rec[tid * 4 + 1] = 0xffffffffu;
    __syncthreads();
    float* X1 = F.out; const float* mods = (const float*)(F.ws + WS_MODS); bf16* U2 = (bf16*)(F.ws + WS_U2);
    const bf16* WH = (const bf16*)(F.ws + WS_WRT); const bf16* WL = WH + 48 * 1024;
    unsigned* cnt = (unsigned*)(F.ws + WS_CTL) + CW_CNT; unsigned* lst = (unsigned*)(F.ws + WS_LST); float* lstw = (float*)(F.ws + WS_LSTW);
    const int task = F.vcu * 4 + wid;
    if (wid < 4 && task < NTOK / 16) {
        const int m = task * 16 + tok, b = m >> 12;
        float* xr = X1 + (size_t)m * 1024 + kg * 8;
        float s = 0.f, q = 0.f;
#pragma unroll 8
        for (int j = 0; j < 32; ++j) { const f32x4 a = *(const f32x4*)(xr + 32 * j), c = *(const f32x4*)(xr + 32 * j + 4);
            s += (a[0] + a[1]) + (a[2] + a[3]) + (c[0] + c[1]) + (c[2] + c[3]);
            q += (a[0] * a[0] + a[1] * a[1]) + (a[2] * a[2] + a[3] * a[3]) + (c[0] * c[0] + c[1] * c[1]) + (c[2] * c[2] + c[3] * c[3]); }
        s += __shfl_xor(s, 16); s += __shfl_xor(s, 32); q += __shfl_xor(q, 16); q += __shfl_xor(q, 32);
        const float mean = s * (1.f / 1024.f), var = fmaxf(q * (1.f / 1024.f) - mean * mean, 0.f), rstd = rsqrtf(var + LN_EPS);
        f32x4 acc[3];
#pragma unroll
        for (int n = 0; n < 3; ++n) acc[n] = (f32x4){0.f, 0.f, 0.f, 0.f};
        const float* lg = args.in[12] + kg * 8; const float* lb = args.in[13] + kg * 8;
        const float* sc2 = mods + b * 6144 + 4 * 1024 + kg * 8; const float* sh2 = mods + b * 6144 + 3 * 1024 + kg * 8;
        const bf16* wh = WH + (size_t)tok * 1024 + kg * 8; const bf16* wl = WL + (size_t)tok * 1024 + kg * 8;
        bf16* u2r = U2 + (size_t)m * 1024 + kg * 8;
#pragma unroll 2
        for (int j = 0; j < 32; ++j) {
            const int o = 32 * j;
            const f32x4 xa = *(const f32x4*)(xr + o), xb = *(const f32x4*)(xr + o + 4);
            const f32x4 ga = *(const f32x4*)(lg + o), gb = *(const f32x4*)(lg + o + 4), ba = *(const f32x4*)(lb + o), bb = *(const f32x4*)(lb + o + 4);
            const f32x4 ca = *(const f32x4*)(sc2 + o), cb = *(const f32x4*)(sc2 + o + 4), ha = *(const f32x4*)(sh2 + o), hb = *(const f32x4*)(sh2 + o + 4);
            bf16x8 wfh[3], wfl[3];
#pragma unroll
            for (int n = 0; n < 3; ++n) { wfh[n] = *(const bf16x8*)(wh + (size_t)n * 16 * 1024 + o); wfl[n] = *(const bf16x8*)(wl + (size_t)n * 16 * 1024 + o); }
            const f32x4 x1a = (xa - mean) * rstd * ga + ba, x1b = (xb - mean) * rstd * gb + bb;
            *(f32x4*)(xr + o) = x1a; *(f32x4*)(xr + o + 4) = x1b;
            const f32x4 ua = x1a * (ca + 1.f) + ha, ub = x1b * (cb + 1.f) + hb;
            const u32x4 uh = pack8(ua, ub);
            *(u32x4*)(u2r + o) = uh;
            f32x4 ra, rb; unpack8(uh, ra, rb);
            const u32x4 ul = pack8(ua - ra, ub - rb);
            const bf16x8 fh = __builtin_bit_cast(bf16x8, uh), fl = __builtin_bit_cast(bf16x8, ul);
#pragma unroll
            for (int n = 0; n < 3; ++n) {
                acc[n] = __builtin_amdgcn_mfma_f32_16x16x32_bf16(wfh[n], fh, acc[n], 0, 0, 0);
                acc[n] = __builtin_amdgcn_mfma_f32_16x16x32_bf16(wfh[n], fl, acc[n], 0, 0, 0);
                acc[n] = __builtin_amdgcn_mfma_f32_16x16x32_bf16(wfl[n], fh, acc[n], 0, 0, 0);
            }
        }
#pragma unroll
        for (int n = 0; n < 3; ++n)
#pragma unroll
            for (int r = 0; r < 4; ++r) LGT[tok * 48 + 16 * n + 4 * kg + r] = acc[n][r];
        LDS_WAIT();
        if (lane < 16) {
            const LAS float* lt = LGT + lane * 48;
            float gl[4];
#pragma unroll
            for (int j = 0; j < 4; ++j) gl[j] = lt[j] + args.in[15][j];
            int gi = 0; float gm = gl[0];
#pragma unroll
            for (int j = 1; j < 4; ++j) if (gl[j] > gm) { gm = gl[j]; gi = j; }
            float gs = 0.f;
#pragma unroll
            for (int j = 0; j < 4; ++j) gs += __expf(gl[j] - gm);
            const float gval = 1.f / gs;
            float el[8];
#pragma unroll
            for (int j = 0; j < 8; ++j) el[j] = lt[4 + gi * 8 + j] + args.in[17][gi * 8 + j];
            int i1 = 0; float v1 = el[0];
#pragma unroll
            for (int j = 1; j < 8; ++j) if (el[j] > v1) { v1 = el[j]; i1 = j; }
            int i2 = (i1 == 0) ? 1 : 0; float v2 = (i1 == 0) ? el[1] : el[0];
#pragma unroll
            for (int j = 1; j < 8; ++j) if (j != i1 && el[j] > v2) { v2 = el[j]; i2 = j; }
            const float w1 = 1.f / (1.f + __expf(v2 - v1)), w2 = 1.f - w1;
            const int E1 = gi * 8 + i1, E2 = gi * 8 + i2, slot = wid * 16 + lane;
            const unsigned r1 = __hip_atomic_fetch_add(lcnt + E1, 1u, __ATOMIC_RELAXED, __HIP_MEMORY_SCOPE_WORKGROUP), r2 = __hip_atomic_fetch_add(lcnt + E2, 1u, __ATOMIC_RELAXED, __HIP_MEMORY_SCOPE_WORKGROUP);
            rec[slot * 4 + 0] = (unsigned)E1 | ((unsigned)E2 << 8) | (r1 << 16) | (r2 << 24); rec[slot * 4 + 1] = (unsigned)(task * 16 + lane);
            rec[slot * 4 + 2] = __float_as_uint(gval * w1); rec[slot * 4 + 3] = __float_as_uint(gval * w2);
        }
    }
    __syncthreads();
    if (tid < 32) { const unsigned n = lcnt[tid]; lbase[tid] = n ? atomicAdd(&cnt[tid * CNT_STRIDE], n) : 0u; }
    __syncthreads();
    if (tid < 64) {
        const unsigned r0 = rec[tid * 4], m = rec[tid * 4 + 1]; const unsigned E1 = r0 & 255u, E2 = (r0 >> 8) & 255u, p1 = lbase[E1] + ((r0 >> 16) & 255u), p2 = lbase[E2] + (r0 >> 24);
        if (m < (unsigned)NTOK) {
            lst[(size_t)E1 * NTOK + p1] = m * 2u; lstw[(size_t)E1 * NTOK + p1] = __uint_as_float(rec[tid * 4 + 2]);
            lst[(size_t)E2 * NTOK + p2] = m * 2u + 1u; lstw[(size_t)E2 * NTOK + p2] = __uint_as_float(rec[tid * 4 + 3]);
        }
    }
    __syncthreads();
}
__device__ __forceinline__ void moe_tiles(Frame& F) {
    LAS int* ts = (LAS int*)(F.lds + LDS_TS);
    __syncthreads();
    if (F.tid == 0) { const unsigned* cnt = (const unsigned*)(F.ws + WS_CTL) + CW_CNT; int a = 0; for (int e = 0; e < 32; ++e) { ts[e] = a; a += (int)((__hip_atomic_load(cnt + e * CNT_STRIDE, __ATOMIC_RELAXED, __HIP_MEMORY_SCOPE_AGENT) + 255u) >> 8); } ts[32] = a; }
    __syncthreads();
}
__device__ __forceinline__ void final_phase(Frame& F, const Args& args) {
    const int gw = F.vcu * NWAVES + F.wave, NGW = F.G * NWAVES, lane = F.lane;
    const float* mods = (const float*)(F.ws + WS_MODS); const bf16* Y = (const bf16*)(F.ws + WS_Y);
#pragma unroll 1
    for (int m = gw; m < NTOK; m += NGW) {
        const int b = m >> 12; f32x4* xr = (f32x4*)(F.out + (size_t)m * 1024) + lane;
        const f32x4* g2 = (const f32x4*)(mods + b * 6144 + 5 * 1024) + lane;
        const u32x2* y0 = (const u32x2*)(Y + (size_t)m * 1024) + lane; const u32x2* y1 = (const u32x2*)(Y + ((size_t)NTOK + m) * 1024) + lane;
        f32x4 v[4]; float s = 0.f;
#pragma unroll
        for (int j = 0; j < 4; ++j) { const u32x2 a = y0[64 * j], c = y1[64 * j];
            const f32x4 y = (f32x4){bflo(a.x) + bflo(c.x), bfhi(a.x) + bfhi(c.x), bflo(a.y) + bflo(c.y), bfhi(a.y) + bfhi(c.y)};
            v[j] = xr[64 * j] * ALPHA + g2[64 * j] * y; s += (v[j][0] + v[j][1]) + (v[j][2] + v[j][3]); }
        const float mean = wave_sum(s) * (1.f / 1024.f); float s2 = 0.f;
#pragma unroll
        for (int j = 0; j < 4; ++j) { v[j] = v[j] - mean; s2 += (v[j][0] * v[j][0] + v[j][1] * v[j][1]) + (v[j][2] * v[j][2] + v[j][3] * v[j][3]); }
        const float rstd = rsqrtf(wave_sum(s2) * (1.f / 1024.f) + LN_EPS);
        const f32x4* lg = (const f32x4*)args.in[21] + lane; const f32x4* lb = (const f32x4*)args.in[22] + lane;
#pragma unroll
        for (int j = 0; j < 4; ++j) xr[64 * j] = v[j] * rstd * lg[64 * j] + lb[64 * j];
    }
}

#if NAIVE_ATTN
__device__ __forceinline__ void attn_naive(Frame& F) {
    const int gw = F.vcu * NWAVES + F.wave, NGW = F.G * NWAVES, lane = F.lane;
    LAS float* pl = (LAS float*)(F.lds) + F.wave * 256;
    bf16* QD = (bf16*)(F.ws + WS_QD); const bf16* KD = (const bf16*)(F.ws + WS_KD); const bf16* VD = (const bf16*)(F.ws + WS_VD);
    float* LSE = (float*)(F.ws + WS_LSE); const float* BT = (const float*)(F.ws + WS_BTAB);
#pragma unroll 1
    for (int w = gw; w < NTOK * 24; w += NGW) {
        const int m = w / 24, gh = w % 24, g = gh >> 3, dil = 1 << (2 * g), b = m >> 12, s = m & 4095;
        const bf16* q = QD + (size_t)m * 1536 + gh * 64;
        float sc[3]; float mx = -INFINITY;
#pragma unroll
        for (int p = 0; p < 3; ++p) {
            const int mm = lane + 64 * p; const int sk = s - mm * dil; float v = -INFINITY;
            if (mm <= 128 && sk >= 0) { const bf16* k = KD + (size_t)(b * SEQ + sk) * 1536 + gh * 64; float d = 0.f; for (int e = 0; e < 64; ++e) d += bf2f(q[e]) * bf2f(k[e]); v = d + BT[gh * 132 + mm]; }
            sc[p] = v; mx = fmaxf(mx, v);
        }
#pragma unroll
        for (int o = 1; o < 64; o <<= 1) mx = fmaxf(mx, __shfl_xor(mx, o));
        float sum = 0.f;
#pragma unroll
        for (int p = 0; p < 3; ++p) { const float e = __expf(sc[p] - mx); if (lane + 64 * p < 256) pl[lane + 64 * p] = e; sum += e; }
        sum = wave_sum(sum);
        LDS_WAIT();
        float o = 0.f;
        for (int mm = 0; mm <= 128; ++mm) { const int sk = s - mm * dil; if (sk >= 0) o += pl[mm] * bf2f(VD[(size_t)(b * SEQ + sk) * 1536 + gh * 64 + lane]); }
        LDS_WAIT();
        QD[(size_t)m * 1536 + gh * 64 + lane] = f2bf(o / sum);
        if (lane == 0) LSE[(size_t)m * 24 + gh] = mx + __logf(sum);
    }
    __syncthreads();
}
#endif
#if NAIVE_GLA || DBG_GLA_DIFF
__device__ __forceinline__ void gla_naive(Frame& F, const Args& args) {
    const int tid = F.tid;
    LAS float* A = (LAS float*)F.lds;
    LAS float* Qs = A + 8192; LAS float* Ks = Qs + 8192; LAS float* Vs = Ks + 8192;
    LAS float* Os = Vs + 1024;
    const bf16* QA = (const bf16*)(F.ws + WS_QA); const bf16* KA = (const bf16*)(F.ws + WS_KA); const bf16* VA = (const bf16*)(F.ws + WS_VA);
    const float* LR = (const float*)(F.ws + WS_LR); float* OF = (float*)(F.ws + WS_DS);
    const int U = F.vcu; if (U < 256) {
    const int bh = U >> 4, vt = U & 15, b = bh >> 2, h = bh & 3;
    float st[8];
#pragma unroll
    for (int j = 0; j < 8; ++j) st[j] = 0.f;
    const int v = tid & 15, kg = (tid >> 4) & 15;
    for (int c = 0; c < 64; ++c) {
        const size_t tok0 = (size_t)b * SEQ + c * 64;
        __syncthreads();
        for (int i = tid; i < 8192; i += NTHR) { const int t = i >> 7, k = i & 127; float lg = args.in[7][h * 128 + k];
            for (int j = 0; j < 16; ++j) lg += LR[(tok0 + t) * 16 + j] * args.in[6][j * 512 + h * 128 + k];
            A[i] = __expf(log_sigmoid_(lg) * (1.f / 16.f)); Qs[i] = bf2f(QA[(tok0 + t) * 512 + h * 128 + k]); Ks[i] = bf2f(KA[(tok0 + t) * 512 + h * 128 + k]); }
        for (int i = tid; i < 1024; i += NTHR) { Vs[i] = bf2f(VA[(tok0 + (i >> 4)) * 1024 + h * 256 + vt * 16 + (i & 15)]); Os[i] = 0.f; }
        __syncthreads();
        if (tid < 256) {
            for (int t = 0; t < 64; ++t) { const float vv = Vs[t * 16 + v]; float o = 0.f;
#pragma unroll
                for (int j = 0; j < 8; ++j) { const int k = kg * 8 + j; st[j] = st[j] * A[t * 128 + k] + Ks[t * 128 + k] * vv; o += Qs[t * 128 + k] * st[j]; }
                o += __shfl_xor(o, 16); o += __shfl_xor(o, 32);
                if ((kg & 3) == 0) Os[(tid >> 6) * 1024 + t * 16 + v] = o;
            }
        }
        __syncthreads();
        for (int i = tid; i < 1024; i += NTHR) OF[(tok0 + (i >> 4)) * 1024 + h * 256 + vt * 16 + (i & 15)] = (Os[i] + Os[1024 + i]) + (Os[2048 + i] + Os[3072 + i]);
    }
    }
    __syncthreads();
}
__device__ __forceinline__ void gla_naive_norm(Frame& F, const Args& args, size_t ws_out = WS_YGLA) {
    const int gw = F.vcu * NWAVES + F.wave, NGW = F.G * NWAVES, lane = F.lane;
    const float* OF = (const float*)(F.ws + WS_DS); const bf16* RA = (const bf16*)(F.ws + WS_RA); bf16* YG = (bf16*)(F.ws + ws_out);
#pragma unroll 1
    for (int w = gw; w < NTOK * 4; w += NGW) {
        const size_t e = (size_t)(w >> 2) * 1024 + (w & 3) * 256 + lane * 4; const f32x4 o = *(const f32x4*)(OF + e);
        const float ss = wave_sum(o[0] * o[0] + o[1] * o[1] + o[2] * o[2] + o[3] * o[3]); const float rs = rsqrtf(ss * (1.f / 256.f) + LN_EPS);
        const float* ng = args.in[8] + (w & 3) * 256 + lane * 4;
#pragma unroll
        for (int j = 0; j < 4; ++j) YG[e + j] = f2bf(o[j] * rs * ng[j] * bf2f(RA[e + j]));
    }
}
#endif

enum { PH_P0 = 0, PH_P0B, PH_INPROJ, PH_ATTN, PH_GLAA, PH_SCAN, PH_GLAC, PH_PROJ, PH_OUT, PH_LN1, PH_MOE1, PH_MOE2, PH_FINAL, NPH };

__global__ void __launch_bounds__(NTHR, 2) mega_fwd(Args args) {
    extern __shared__ __attribute__((aligned(16))) unsigned char lds_raw[];
    Frame F;
    F.lds = (LAS unsigned char*)lds_raw;
    F.tid = threadIdx.x; F.lane = F.tid & 63; F.wave = __builtin_amdgcn_readfirstlane(F.tid >> 6);
    F.G = gridDim.x; { const int bx = blockIdx.x; F.vcu = (F.G % 8 == 0) ? (bx % 8) * (F.G / 8) + bx / 8 : bx; }
    F.ws = args.ws; F.out = args.out;
    for (int u = F.tid; u < (LDS_BYTES - LDSCTL_OFF) / 4; u += NTHR) ((LAS unsigned*)(F.lds + LDSCTL_OFF))[u] = 0u;
    __syncthreads();
    const int lo = args.ph_lo, hi = args.ph_hi;
    XcdBarrier bar; bar.bar = (unsigned*)(F.ws + WS_CTL) + CW_BAR; bar.x = 0; bar.st = nullptr;
    if (hi - lo > 1) bar = xcd_barrier_post((unsigned*)(F.ws + WS_CTL) + CW_BAR, (volatile LAS unsigned*)(F.lds + LDSCTL_OFF));
#ifndef PHASE_MASK
#define PHASE_MASK 0xFFFF
#endif
#define IN(k) (((PHASE_MASK >> (k)) & 1) && lo <= (k) && (k) < hi)
#define SEAM(k) do { if (IN(k) && IN((k) + 1)) xcd_barrier(bar); } while (0)
    unsigned char* ws = F.ws;
    bf16* GA = (bf16*)F.out; bf16* GD = GA + (size_t)NTOK * 1024;

    if (IN(PH_P0)) { frame_refresh(F); p0_phase(F, args); } SEAM(PH_P0);
    if (IN(PH_P0B)) { frame_refresh(F); p0b_phase(F, args); } SEAM(PH_P0B);
    if (IN(PH_INPROJ)) { frame_refresh(F);
        pg8::DenseOrder S; S.init(NTOK, INPAD, 1024, F.G, (int)blockIdx.x);
        run_gemm(F, (const bf16*)(ws + WS_U), (const bf16*)(ws + WS_WIN), 1024, S, EpiInProj{ws, GA, GD});
    } SEAM(PH_INPROJ);
    if (IN(PH_ATTN)) { frame_refresh(F);
#if NAIVE_ATTN
        attn_naive(F);
#else
        attn_phase(F);
#endif
    } SEAM(PH_ATTN);
    if (IN(PH_GLAA)) { frame_refresh(F);
#if NAIVE_GLA
        gla_naive(F, args);
#else
        gla_a_phase(F, args);
#endif
        combine_phase(F);
    } SEAM(PH_GLAA);
    if (IN(PH_SCAN)) { frame_refresh(F);
#if !NAIVE_GLA
        gla_scan_phase(F);
#endif
    } SEAM(PH_SCAN);
    if (IN(PH_GLAC)) { frame_refresh(F);
#if NAIVE_GLA
        gla_naive_norm(F, args);
#else
        gla_c_phase(F, args);
#endif
    } SEAM(PH_GLAC);
    if (IN(PH_PROJ)) { frame_refresh(F);
        const bool conv_first = (blockIdx.x & 8) != 0;
        if (conv_first) { convert_experts(F, args); __syncthreads(); }
        pg8::DenseOrder S; S.init(NTOK, 1024, 512, F.G, (int)blockIdx.x);
        run_gemm(F, (const bf16*)(ws + WS_YATT), (const bf16*)(ws + WS_WPA), 512, S, EpiProjA{GD, (bf16*)(ws + WS_TT)});
        VM_WAIT(); __syncthreads();
        pg8::DenseOrder S2; S2.init(NTOK, 1024, 1024, F.G, (int)blockIdx.x);
        run_gemm(F, (const bf16*)(ws + WS_YGLA), (const bf16*)(ws + WS_WPG), 1024, S2, EpiProjG{GA, (const bf16*)(ws + WS_TT), (bf16*)(ws + WS_MERGED)});
        if (!conv_first) convert_experts(F, args);
    } SEAM(PH_PROJ);
    if (IN(PH_OUT)) { frame_refresh(F);
        pg8::DenseOrder S; S.init(NTOK, 1024, 1024, F.G, (int)blockIdx.x);
        run_gemm(F, (const bf16*)(ws + WS_MERGED), (const bf16*)(ws + WS_WOUT), 1024, S, EpiOut{args.in[0], (const float*)(ws + WS_MODS), F.out});
    } SEAM(PH_OUT);
    if (IN(PH_LN1)) { frame_refresh(F); ln1_router_phase(F, args); } SEAM(PH_LN1);
    if (IN(PH_MOE1)) { frame_refresh(F);
        moe_tiles(F);
        MoeOrder S{(const LAS int*)(F.lds + LDS_TS), (const unsigned*)(ws + WS_CTL) + CW_CNT, (const unsigned*)(ws + WS_LST), F.G, F.vcu, 0};
        run_gemm(F, (const bf16*)(ws + WS_U2), (const bf16*)(ws + WS_WGU), 1024, S, EpiMoeUp{(bf16*)(ws + WS_H)});
    } SEAM(PH_MOE1);
    if (IN(PH_MOE2)) { frame_refresh(F);
        moe_tiles(F);
        MoeOrder S{(const LAS int*)(F.lds + LDS_TS), (const unsigned*)(ws + WS_CTL) + CW_CNT, (const unsigned*)(ws + WS_LST), F.G, F.vcu, 1};
        run_gemm(F, (const bf16*)(ws + WS_H), (const bf16*)(ws + WS_WDN), 512, S, EpiMoeDown{(const unsigned*)(ws + WS_CTL) + CW_CNT, (const unsigned*)(ws + WS_LST), (const float*)(ws + WS_LSTW), (bf16*)(ws + WS_Y)});
    } SEAM(PH_MOE2);
    if (IN(PH_FINAL)) { frame_refresh(F); final_phase(F, args); }
#if DBG_GLA_DIFF
    if (lo == 13) { frame_refresh(F); gla_naive(F, args); }
    if (lo == 14) { frame_refresh(F); gla_naive_norm(F, args, WS_TT); }
    if (lo == 15) { frame_refresh(F);
        const bf16* ya = (const bf16*)(ws + DBG_SRC);
        for (size_t i = (size_t)blockIdx.x * NTHR + F.tid; i < (size_t)NTOK * 1024; i += (size_t)F.G * NTHR) { float d = bf2f(ya[i]); if (!(fabsf(d) < 1e30f)) d = 1e4f; F.out[i] = d; } }
#endif
#undef IN
#undef SEAM
}

extern "C" void kernel_launch(void* const* d_in, const int* in_sizes, int n_in, void* d_out, int out_size, void* d_ws, size_t ws_size, hipStream_t stream) {
    static int grid = 0;
    if (grid == 0) {
        if (n_in != 23 || out_size != NTOK * D || ws_size < WS_END) { fprintf(stderr, "kernel_launch: unexpected shapes (n_in %d out %d ws %zu, need %zu)\n", n_in, out_size, ws_size, (size_t)WS_END); grid = -1; return; }
        int dev = 0, cus = 0;
        if (hipGetDevice(&dev) != hipSuccess || hipDeviceGetAttribute(&cus, hipDeviceAttributeMultiprocessorCount, dev) != hipSuccess) { grid = -1; return; }
        if (hipFuncSetAttribute((const void*)mega_fwd, hipFuncAttributeMaxDynamicSharedMemorySize, LDS_BYTES) != hipSuccess) { fprintf(stderr, "kernel_launch: hipFuncSetAttribute failed\n"); grid = -1; return; }
        int per_cu = 0;
        if (hipOccupancyMaxActiveBlocksPerMultiprocessor(&per_cu, (const void*)mega_fwd, NTHR, LDS_BYTES) != hipSuccess || per_cu < 1) fprintf(stderr, "kernel_launch: occupancy query reports %d\n", per_cu);
        (void)hipGetLastError();
        grid = cus - (cus % 8);
        if (grid <= 0) grid = cus;
    }
    if (grid < 0) return;
    (void)hipMemsetAsync((char*)d_ws + WS_CTL, 0, CTL_ZERO_BYTES, stream);
    Args a{};
    for (int i = 0; i < 23; ++i) a.in[i] = (const float*)d_in[i];
    a.out = (float*)d_out; a.ws = (unsigned char*)d_ws;
#if DBG_GLA_DIFF
    { const int seq[] = DBG_SEQ;
      for (int k = 0; k < (int)(sizeof(seq) / sizeof(int)); ++k) { a.ph_lo = seq[k]; a.ph_hi = seq[k] + 1; hipLaunchKernelGGL(mega_fwd, dim3(grid), dim3(NTHR), LDS_BYTES, stream, a); } }
#elif MK_MULTI
    { const int seq[] = MULTI_SEQ;
      for (int k = 0; k < (int)(sizeof(seq) / sizeof(int)); ++k) { a.ph_lo = seq[k]; a.ph_hi = seq[k] + 1; hipLaunchKernelGGL(mega_fwd, dim3(grid), dim3(NTHR), LDS_BYTES, stream, a); } }
#else
    a.ph_lo = 0; a.ph_hi = NPH;
    hipLaunchKernelGGL(mega_fwd, dim3(grid), dim3(NTHR), LDS_BYTES, stream, a);
#endif
}
```

```cpp
#include <hip/hip_runtime.h>
#include <cstdio>
#include <cstdint>

#ifndef MK_MULTI
#define MK_MULTI 0
#endif
#ifndef MULTI_SEQ
#define MULTI_SEQ {0, 1, 2, 3, 4, 5, 6, 7, 8, 9, 10, 11, 12}
#endif
#ifndef DBG_GLA_DIFF
#define DBG_GLA_DIFF 0
#define DBG_SEQ {0, 1, 2, 3, 4, 15}
#define DBG_SRC WS_DS
#endif
#ifndef NAIVE_GEMM
#define NAIVE_GEMM 0
#endif
#ifndef NAIVE_ATTN
#define NAIVE_ATTN 0
#endif
#ifndef NAIVE_GLA
#define NAIVE_GLA 0
#endif

#define GAS __attribute__((address_space(1)))
#define LAS __attribute__((address_space(3)))
typedef unsigned short bf16;
typedef short bf16x8 __attribute__((ext_vector_type(8)));
typedef short s16x4 __attribute__((ext_vector_type(4)));
typedef float f32x4 __attribute__((ext_vector_type(4)));
typedef float f32x16 __attribute__((ext_vector_type(16)));
typedef unsigned u32x4 __attribute__((ext_vector_type(4)));
typedef unsigned u32x2 __attribute__((ext_vector_type(2)));

constexpr int NB = 4, SEQ = 4096, NTOK = NB * SEQ, D = 1024;
constexpr int NWAVES = 8, NTHR = 512;
constexpr int INCOLS = 9744, INPAD = 9984;
constexpr float LN_EPS = 1e-5f;
constexpr float ALPHA = 1.189207115002721f;
constexpr int C_QA = 0, C_KA = 512, C_VA = 1024, C_RA = 2048, C_QD = 3072, C_KD = 4608, C_VD = 6144, C_GA = 7680, C_GD = 8704, C_LR = 9728;

constexpr size_t MiB = 1u << 20;
constexpr size_t WS_CTL = 0, CTL_ZERO_BYTES = 256 * 1024;
constexpr size_t WS_MODS = 1 * MiB;
constexpr size_t WS_BTAB = WS_MODS + 128 * 1024;
constexpr size_t WS_WRT = WS_MODS + 256 * 1024;
constexpr size_t WS_WIN = 2 * MiB;
constexpr size_t WS_WPG = 22 * MiB, WS_WPA = 24 * MiB, WS_WOUT = 25 * MiB;
constexpr size_t WS_LR = 27 * MiB;
constexpr size_t WS_LSE = 28 * MiB;
constexpr size_t WS_DECAY = 318 * MiB;
constexpr size_t WS_QA = 30 * MiB, WS_KA = 46 * MiB, WS_VA = 62 * MiB, WS_RA = 94 * MiB;
constexpr size_t WS_QD = 126 * MiB, WS_KD = 174 * MiB, WS_VD = 222 * MiB;
constexpr size_t WS_U = 270 * MiB;
constexpr size_t WS_YGLA = 270 * MiB, WS_YATT = 302 * MiB;
constexpr size_t WS_DS = 174 * MiB;
constexpr size_t WS_MERGED = 30 * MiB;
constexpr size_t WS_T = 222 * MiB;
constexpr size_t WS_TT = 238 * MiB;
constexpr size_t WS_WGU = 126 * MiB;
constexpr size_t WS_WDN = 190 * MiB;
constexpr size_t WS_U2 = 62 * MiB;
constexpr size_t WS_LST = 94 * MiB;
constexpr size_t WS_LSTW = 96 * MiB;
constexpr size_t WS_H = 222 * MiB;
constexpr size_t WS_Y = 262 * MiB;
constexpr size_t WS_END = 326 * MiB;

constexpr int CW_CNT = 8192, CNT_STRIDE = 64;
constexpr int CW_BAR = 1024;

constexpr int LDS_BYTES = 163840;
constexpr int LDSCTL_OFF = 157696;
constexpr int LDS_TS = LDSCTL_OFF + 64;

#define LDS_WAIT() asm volatile("s_waitcnt lgkmcnt(0)" ::: "memory")
#define VM_WAIT() asm volatile("s_waitcnt vmcnt(0)" ::: "memory")

typedef float f32x2_t __attribute__((ext_vector_type(2))); typedef __bf16 bf16x2_t __attribute__((ext_vector_type(2)));
__device__ __forceinline__ unsigned pk2(float lo, float hi) { f32x2_t v = {lo, hi}; bf16x2_t b = __builtin_convertvector(v, bf16x2_t); return __builtin_bit_cast(unsigned, b); }
__device__ __forceinline__ bf16 f2bf(float x) { return (bf16)(pk2(x, 0.f) & 0xffffu); }
__device__ __forceinline__ float bf2f(unsigned short u) { return __uint_as_float(((unsigned)u) << 16); }
__device__ __forceinline__ float bflo(unsigned w) { return __uint_as_float(w << 16); }
__device__ __forceinline__ float bfhi(unsigned w) { return __uint_as_float(w & 0xffff0000u); }
__device__ __forceinline__ float sigmoidf_(float x) { return __builtin_amdgcn_rcpf(1.f + __expf(-x)); }
__device__ __forceinline__ float siluf_(float x) { return x * __builtin_amdgcn_rcpf(1.f + __expf(-x)); }
__device__ __forceinline__ float wave_sum(float v) {
#pragma unroll
    for (int o = 1; o < 64; o <<= 1) v += __shfl_xor(v, o);
    return v;
}
__device__ __forceinline__ int crow(int r, int hi) { return (r & 3) + 8 * (r >> 2) + 4 * hi; }

#define XB_TMO      128
#define XB_XCNT(j)  (256  + 64 * (j))
#define XB_XSUB(j)  (1280 + 64 * (j))
#define XB_XGEN(j)  (2304 + 64 * (j))
#define XB_TOP      3328
#define XB_TOPGEN   3392
#define XCD_BAR_WORDS 3456
#define XB_SPIN_CAP (1u << 18)
__device__ __forceinline__ unsigned xb_ld(unsigned* p)              { return __hip_atomic_load(p, __ATOMIC_RELAXED, __HIP_MEMORY_SCOPE_AGENT); }
__device__ __forceinline__ unsigned xb_add(unsigned* p, unsigned v) { return __hip_atomic_fetch_add(p, v, __ATOMIC_RELAXED, __HIP_MEMORY_SCOPE_AGENT); }
__device__ __forceinline__ unsigned xb_xcc_id() { return (unsigned)__builtin_amdgcn_s_getreg((3 << 11) | 20) & 0xFu; }
#define XB_SPIN(cond, bar) do { unsigned _sp = 0; while (cond) { __builtin_amdgcn_s_sleep(1); \
    if ((++_sp & 255u) == 0u) { if (xb_ld(&(bar)[XB_TMO])) break; if (_sp > XB_SPIN_CAP) { atomicAdd(&(bar)[XB_TMO], 1u); break; } } } } while (0)
struct XcdBarrier { unsigned* bar; unsigned x; volatile LAS unsigned* st; };
__device__ __forceinline__ XcdBarrier xcd_barrier_post(unsigned* bar, volatile LAS unsigned* st) {
    XcdBarrier b; b.bar = bar; b.x = xb_xcc_id(); b.st = st;
    if (threadIdx.x == 0) (void)xb_add(&bar[XB_XCNT(b.x)], 1u);
    return b;
}
__device__ __forceinline__ void xcd_barrier_complete(unsigned* bar, unsigned x, unsigned& nloc, unsigned& nx) {
    const unsigned G = gridDim.x * gridDim.y * gridDim.z;
    unsigned sum, cnt, mine, sp = 0u;
    for (;;) {
        sum = 0u; cnt = 0u; mine = 0u;
#pragma unroll
        for (unsigned j = 0; j < 16; ++j) { const unsigned c = xb_ld(&bar[XB_XCNT(j)]); sum += c; cnt += (c > 0u) ? 1u : 0u; mine = (j == x) ? c : mine; }
        if (sum == G) break;
        __builtin_amdgcn_s_sleep(1);
        if ((++sp & 255u) == 0u) { if (xb_ld(&bar[XB_TMO])) break; if (sp > XB_SPIN_CAP) { atomicAdd(&bar[XB_TMO], 1u); break; } }
    }
    nloc = mine > 0u ? mine : 1u; nx = cnt > 0u ? cnt : 1u;
}
__device__ __forceinline__ void xcd_barrier(const XcdBarrier& b) {
    asm volatile("s_waitcnt vmcnt(0)" ::: "memory");
    __syncthreads();
    if (threadIdx.x == 0) {
        unsigned* bar = b.bar;
        __builtin_amdgcn_s_waitcnt(0);
        unsigned nloc = b.st[0], nx = b.st[1];
        if (nloc == 0u) { xcd_barrier_complete(bar, b.x, nloc, nx); b.st[0] = nloc; b.st[1] = nx; }
        const unsigned old = xb_add(&bar[XB_XSUB(b.x)], 1u);
        const unsigned gen = old / nloc;
        if (old + 1u == (gen + 1u) * nloc) {
            __builtin_amdgcn_fence(__ATOMIC_RELEASE, "agent");
            asm volatile("s_waitcnt vmcnt(0)" ::: "memory");
            const unsigned og = xb_add(&bar[XB_TOP], 1u);
            const unsigned tg = og / nx;
            if (og + 1u == (tg + 1u) * nx) xb_add(&bar[XB_TOPGEN], 1u);
            else XB_SPIN(xb_ld(&bar[XB_TOPGEN]) == tg, bar);
            __builtin_amdgcn_fence(__ATOMIC_ACQUIRE, "agent");
            xb_add(&bar[XB_XGEN(b.x)], 1u);
            asm volatile("s_waitcnt vmcnt(0)" ::: "memory");
        } else {
            XB_SPIN(xb_ld(&bar[XB_XGEN(b.x)]) == gen, bar);
            __builtin_amdgcn_fence(__ATOMIC_ACQUIRE, "agent");
            asm volatile("s_waitcnt vmcnt(0)" ::: "memory");
        }
    }
    __syncthreads();
}

struct Args { const float* in[23]; float* out; unsigned char* ws; int ph_lo, ph_hi; };
struct Frame {
    LAS unsigned char* lds;
    int tid, lane, wave, vcu, G;
    unsigned char* ws; float* out;
};
__device__ __forceinline__ void frame_refresh(Frame& F) { int t = threadIdx.x; asm volatile("" : "+v"(t)); F.tid = t; F.lane = t & 63; }

namespace pg8 {
constexpr int BM = 256, BK = 64, HALF = 128, HTB = HALF * BK * 2, STAGE_BYTES = 8 * HTB, NXCD = 8, WGM = 8;
__host__ __device__ __forceinline__ int lds_byte(int r, int c) { const int st = (r >> 4) * 2 + (c >> 5), rr = r & 15, cc = c & 31, ob = rr * 64 + cc * 2; return st * 1024 + (ob ^ (((ob >> 9) & 1) << 5)); }
__host__ __device__ __forceinline__ void stage_rc(int b, int& R, int& C) { const int st = b / 1024, sb = b % 1024, swz = sb ^ (((sb >> 9) & 1) << 5); R = (st >> 1) * 16 + swz / 64; C = (st & 1) * 32 + (swz % 64) / 2; }
__host__ __device__ __forceinline__ int perm32(int rho) { const int n = rho >> 4, i = rho & 15; return 8 * (i >> 2) + 4 * n + (i & 3); }

struct Unit { int pm, pn, e, mt; };

struct DenseOrder {
    static constexpr bool GATHER = false;
    int nM, nN, nwg, G, c, K;
    __device__ void init(int M, int N, int K_, int G_, int c_) { nM = M / BM; nN = N / BM; nwg = nM * nN; G = G_; c = c_; K = K_; }
    __device__ __forceinline__ bool next(int i, Unit& u) const {
        const long L = (long)i * G + c; if (L >= nwg) return false;
        int wgid = (int)L; { const int q = nwg / NXCD, r = nwg % NXCD, xcd = wgid % NXCD, off = wgid / NXCD; wgid = (xcd < r ? xcd * (q + 1) : r * (q + 1) + (xcd - r) * q) + off; }
        const int nig = WGM * nN, gid = wgid / nig, fm = gid * WGM, gsz = (nM - fm) < WGM ? (nM - fm) : WGM;
        u.pm = fm + ((wgid % nig) % gsz); u.pn = (wgid % nig) / gsz; u.e = 0; u.mt = 0; return true;
    }
    __device__ __forceinline__ size_t a_base(const Unit& u) const { return (size_t)u.pm * BM * K * 2; }
    __device__ __forceinline__ unsigned a_lane(const Unit&, int r) const { return (unsigned)r * (unsigned)K * 2u; }
    __device__ __forceinline__ size_t b_off(const Unit& u) const { return (size_t)u.pn * BM * K * 2; }
};

template <class Epi, class Sched>
__device__ __forceinline__ void gemm_phase(LAS unsigned char* lds, const bf16* Aptr, const bf16* Bptr, int K, const Sched& S, const Epi& E) {
    int tid_ = threadIdx.x; asm volatile("" : "+v"(tid_));
    const int tid = tid_, wid = __builtin_amdgcn_readfirstlane(tid >> 6), lane = tid & 63, wr = wid >> 2, wc = wid & 3, fr = lane & 15, fq = lane >> 4;
    const int nt = K / BK;
    int RA[2]; unsigned CA2[2], voffB[2];
#pragma unroll
    for (int i = 0; i < 2; ++i) { int R, C; stage_rc(tid * 16 + i * 8192, R, C); const int Rb = (R & ~31) + perm32(R & 31);
        RA[i] = R; CA2[i] = (unsigned)C * 2u; voffB[i] = (unsigned)(Rb * K + C) * 2u; }
    const size_t kstep = (size_t)(BK * 2);
    const size_t hstep = (size_t)HALF * K * 2;
    const unsigned ldsw = (unsigned)wid * 1024u;
    const int aoff = lds_byte(wr * 64 + fr, fq * 8), boff = lds_byte(wc * 32 + fr, fq * 8);
    const char* Abase = (const char*)Aptr;
#define PG8_SA(b, h) (((b) * 2 + (h)) * HTB)
#define PG8_SB(b, h) ((4 + (b) * 2 + (h)) * HTB)
#define PG8_STAGE(bufoff, gbase, voff) do { _Pragma("unroll") for (int _i = 0; _i < 2; ++_i) \
        __builtin_amdgcn_global_load_lds((const unsigned*)((const char*)(gbase) + (voff)[_i]), (LAS unsigned*)(lds + (bufoff) + ldsw + _i * 8192), 16, 0, 0); } while (0)
#define PG8_LDA(dst, b, h) do { _Pragma("unroll") for (int m = 0; m < 4; ++m) _Pragma("unroll") for (int k = 0; k < 2; ++k) dst[m][k] = *(const LAS bf16x8*)(lds + PG8_SA(b, h) + aoff + m * 2048 + k * 1024); } while (0)
#define PG8_LDB(dst, b, h) do { _Pragma("unroll") for (int n = 0; n < 2; ++n) _Pragma("unroll") for (int k = 0; k < 2; ++k) dst[n][k] = *(const LAS bf16x8*)(lds + PG8_SB(b, h) + boff + n * 2048 + k * 1024); } while (0)
#define PG8_MMA(ai, bj, At, Bt) do { __builtin_amdgcn_s_setprio(1); _Pragma("unroll") for (int m = 0; m < 4; ++m) _Pragma("unroll") for (int n = 0; n < 2; ++n) _Pragma("unroll") for (int k = 0; k < 2; ++k) \
        acc[ai][bj][m][n] = __builtin_amdgcn_mfma_f32_16x16x32_bf16(Bt[n][k], At[m][k], acc[ai][bj][m][n], 0, 0, 0); __builtin_amdgcn_s_setprio(0); } while (0)
#define PG8_WAIT_V(n) asm volatile("s_waitcnt vmcnt(" #n ")" ::: "memory")
#define PG8_WAIT_L(n) asm volatile("s_waitcnt lgkmcnt(" #n ")" ::: "memory")
#define PG8_BAR __builtin_amdgcn_s_barrier()
#define PG8_SCHED __builtin_amdgcn_sched_barrier(0)
    Unit cur, nxt; int ui = 0;
    if (!S.next(0, cur)) return;
    f32x4 acc[2][2][4][2];
#pragma unroll
    for (int a = 0; a < 2; ++a)
#pragma unroll
        for (int b = 0; b < 2; ++b)
#pragma unroll
            for (int m = 0; m < 4; ++m)
#pragma unroll
                for (int n = 0; n < 2; ++n) acc[a][b][m][n] = (f32x4){0.f, 0.f, 0.f, 0.f};
    bf16x8 At[4][2], B0[2][2], B1[2][2];
    unsigned vA0[2], vA1[2], nA0[2], nA1[2];
#pragma unroll
    for (int i = 0; i < 2; ++i) { vA0[i] = S.a_lane(cur, RA[i]) + CA2[i]; vA1[i] = S.a_lane(cur, HALF + RA[i]) + CA2[i]; }
    const char* cB = (const char*)Bptr + S.b_off(cur);
    const char* cA = Abase + S.a_base(cur);
    if (Sched::GATHER) VM_WAIT();
    PG8_STAGE(PG8_SB(0, 0), cB, voffB); PG8_STAGE(PG8_SB(0, 1), cB + hstep, voffB); PG8_STAGE(PG8_SA(0, 0), cA, vA0); PG8_STAGE(PG8_SA(0, 1), cA, vA1);
    if (wr == 1) PG8_BAR;
    PG8_WAIT_V(2); PG8_BAR;
    PG8_STAGE(PG8_SB(1, 0), cB + kstep, voffB); PG8_STAGE(PG8_SA(1, 0), cA + kstep, vA0); PG8_STAGE(PG8_SB(1, 1), cB + hstep + kstep, voffB);
    PG8_WAIT_V(6); PG8_BAR;
    for (;;) {
        const bool has_next = S.next(ui + 1, nxt);
        const char* nB = cB; const char* nA = cA;
        if (has_next) {
            int t2 = tid; if (Sched::GATHER) asm volatile("" : "+v"(t2));
#pragma unroll
            for (int i = 0; i < 2; ++i) { int R, C; stage_rc(t2 * 16 + i * 8192, R, C); nA0[i] = S.a_lane(nxt, R) + (unsigned)C * 2u; nA1[i] = S.a_lane(nxt, HALF + R) + (unsigned)C * 2u; }
            nB = (const char*)Bptr + S.b_off(nxt); nA = Abase + S.a_base(nxt);
            if (Sched::GATHER) VM_WAIT();
        } else {
#pragma unroll
            for (int i = 0; i < 2; ++i) { nA0[i] = vA0[i]; nA1[i] = vA1[i]; }
        }
        for (int t = 0; t < nt; t += 2) {
            const bool last = (t == nt - 2);
            const size_t k1 = (size_t)(t + 1) * kstep;
            const size_t k2 = (size_t)(t + 2) * kstep;
            unsigned w0[2], w1[2];
#pragma unroll
            for (int i = 0; i < 2; ++i) { w0[i] = last ? nA0[i] : vA0[i]; w1[i] = last ? nA1[i] : vA1[i]; }
            const char* b2 = last ? nB : cB + (size_t)(t + 2) * kstep; const char* b3 = b2 + kstep;
            const char* a1p = cA + k1; const char* a2p = last ? nA : cA + k2; const char* a3p = a2p + kstep;
            PG8_LDB(B0, 0, 0); PG8_LDB(B1, 0, 1); PG8_SCHED; PG8_LDA(At, 0, 0); PG8_STAGE(PG8_SA(1, 1), a1p, vA1);
            PG8_WAIT_V(8); PG8_WAIT_L(0); PG8_BAR; PG8_MMA(0, 0, At, B0); PG8_MMA(0, 1, At, B1); PG8_BAR; PG8_SCHED;
            PG8_LDA(At, 0, 1); PG8_STAGE(PG8_SB(0, 0), b2, voffB); PG8_STAGE(PG8_SB(0, 1), b2 + hstep, voffB); PG8_STAGE(PG8_SA(0, 0), a2p, w0);
            PG8_WAIT_V(8); PG8_WAIT_L(0); PG8_BAR; PG8_MMA(1, 0, At, B0); PG8_MMA(1, 1, At, B1); PG8_BAR; PG8_SCHED;
            PG8_LDB(B0, 1, 0); PG8_LDB(B1, 1, 1); PG8_SCHED; PG8_LDA(At, 1, 0); PG8_STAGE(PG8_SA(0, 1), a2p, w1);
            PG8_WAIT_V(8); PG8_WAIT_L(0); PG8_BAR; PG8_MMA(0, 0, At, B0); PG8_MMA(0, 1, At, B1); PG8_BAR; PG8_SCHED;
            PG8_LDA(At, 1, 1); PG8_STAGE(PG8_SB(1, 0), b3, voffB); PG8_STAGE(PG8_SB(1, 1), b3 + hstep, voffB); PG8_STAGE(PG8_SA(1, 0), a3p, w0);
            PG8_WAIT_V(8); PG8_WAIT_L(0); PG8_BAR; PG8_MMA(1, 0, At, B0); PG8_MMA(1, 1, At, B1); PG8_BAR; PG8_SCHED;
        }
        if (wr == 0) PG8_BAR;
        E(acc, cur, wr, wc, fr, fq);
        if (!has_next) break;
#pragma unroll
        for (int a = 0; a < 2; ++a)
#pragma unroll
            for (int b = 0; b < 2; ++b)
#pragma unroll
                for (int m = 0; m < 4; ++m)
#pragma unroll
                    for (int n = 0; n < 2; ++n) acc[a][b][m][n] = (f32x4){0.f, 0.f, 0.f, 0.f};
        cur = nxt; cB = nB; cA = nA; ++ui;
#pragma unroll
        for (int i = 0; i < 2; ++i) { vA0[i] = nA0[i]; vA1[i] = nA1[i]; }
        if (wr == 1) PG8_BAR;
    }
    PG8_WAIT_V(0);
    PG8_BAR;
#undef PG8_SA
#undef PG8_SB
#undef PG8_STAGE
#undef PG8_LDA
#undef PG8_LDB
#undef PG8_MMA
#undef PG8_WAIT_V
#undef PG8_WAIT_L
#undef PG8_BAR
#undef PG8_SCHED
}

template <class Epi, class Sched>
__device__ __forceinline__ void gemm_naive(const bf16* Aptr, const bf16* Bptr, int K, const Sched& S, const Epi& E) {
    Unit u;
    for (int i = 0; S.next(i, u); ++i) {
        const char* cB = (const char*)Bptr + S.b_off(u);
        for (int ch = threadIdx.x; ch < 256 * 32; ch += NTHR) {
            const int r = ch >> 5, c = (ch & 31) * 8;
            const bf16* a = (const bf16*)((const char*)Aptr + S.a_base(u) + S.a_lane(u, r));
            float s[8];
#pragma unroll
            for (int j = 0; j < 8; ++j) s[j] = 0.f;
            for (int k = 0; k < K; k += 8) {
                const u32x4 av = *(const u32x4*)(a + k);
                float af[8] = {bflo(av.x), bfhi(av.x), bflo(av.y), bfhi(av.y), bflo(av.z), bfhi(av.z), bflo(av.w), bfhi(av.w)};
#pragma unroll
                for (int j = 0; j < 8; ++j) {
                    const u32x4 bv = *(const u32x4*)((const bf16*)cB + (size_t)(c + j) * K + k);
                    s[j] += af[0] * bflo(bv.x) + af[1] * bfhi(bv.x) + af[2] * bflo(bv.y) + af[3] * bfhi(bv.y) + af[4] * bflo(bv.z) + af[5] * bfhi(bv.z) + af[6] * bflo(bv.w) + af[7] * bfhi(bv.w);
                }
            }
            E.chunk(u, r, c, (f32x4){s[0], s[1], s[2], s[3]}, (f32x4){s[4], s[5], s[6], s[7]});
        }
    }
}

template <class F> struct EpiWrap {
    F f;
    __device__ __forceinline__ void operator()(const f32x4 (&acc)[2][2][4][2], const Unit& u, int wr, int wc, int fr, int fq) const {
#pragma unroll
        for (int ai = 0; ai < 2; ++ai)
#pragma unroll
            for (int m = 0; m < 4; ++m) {
                const int r = ai * HALF + wr * 64 + m * 16 + fr;
#pragma unroll
                for (int bj = 0; bj < 2; ++bj) f.chunk(u, r, bj * HALF + wc * 32 + 8 * fq, acc[ai][bj][m][0], acc[ai][bj][m][1]);
            }
    }
    __device__ __forceinline__ void chunk(const Unit& u, int r, int c, f32x4 v0, f32x4 v1) const { f.chunk(u, r, c, v0, v1); }
};
}
using pg8::Unit;

template <class F, class Sched>
__device__ __forceinline__ void run_gemm(Frame& Fm, const bf16* A, const bf16* Bt, int K, const Sched& S, const F& f) {
    pg8::EpiWrap<F> E{f};
#if NAIVE_GEMM
    pg8::gemm_naive(A, Bt, K, S, E);
    VM_WAIT(); __syncthreads();
#else
    pg8::gemm_phase(Fm.lds, A, Bt, K, S, E);
#endif
}

__device__ __forceinline__ u32x4 pack8(f32x4 a, f32x4 b) { u32x4 w; w.x = pk2(a[0], a[1]); w.y = pk2(a[2], a[3]); w.z = pk2(b[0], b[1]); w.w = pk2(b[2], b[3]); return w; }
__device__ __forceinline__ void unpack8(u32x4 w, f32x4& a, f32x4& b) { a = (f32x4){bflo(w.x), bfhi(w.x), bflo(w.y), bfhi(w.y)}; b = (f32x4){bflo(w.z), bfhi(w.z), bflo(w.w), bfhi(w.w)}; }

struct EpiInProj {
    unsigned char* ws; bf16* ga; bf16* gd;
    __device__ __forceinline__ void chunk(const Unit& u, int r, int c, f32x4 v0, f32x4 v1) const {
        const int row = u.pm * 256 + r, col = u.pn * 256 + c;
        bf16* dst; float sc = 1.f; int act = 0;
        if (col < C_KA)      { dst = (bf16*)(ws + WS_QA) + (size_t)row * 512 + (col - C_QA); sc = 0.08838834764831845f; }
        else if (col < C_VA) { dst = (bf16*)(ws + WS_KA) + (size_t)row * 512 + (col - C_KA); }
        else if (col < C_RA) { dst = (bf16*)(ws + WS_VA) + (size_t)row * 1024 + (col - C_VA); }
        else if (col < C_QD) { dst = (bf16*)(ws + WS_RA) + (size_t)row * 1024 + (col - C_RA); act = 1; }
        else if (col < C_KD) { dst = (bf16*)(ws + WS_QD) + (size_t)row * 1536 + (col - C_QD); sc = 0.125f; }
        else if (col < C_VD) { dst = (bf16*)(ws + WS_KD) + (size_t)row * 1536 + (col - C_KD); }
        else if (col < C_GA) { dst = (bf16*)(ws + WS_VD) + (size_t)row * 1536 + (col - C_VD); }
        else if (col < C_GD) { dst = ga + (size_t)row * 1024 + (col - C_GA); act = 2; }
        else if (col < C_LR) { dst = gd + (size_t)row * 1024 + (col - C_GD); act = 2; }
        else {
            if (col < C_LR + 16) { float* l = (float*)(ws + WS_LR) + (size_t)row * 16 + (col - C_LR); *(f32x4*)l = v0; *(f32x4*)(l + 4) = v1; }
            return;
        }
        if (act == 1) {
#pragma unroll
            for (int j = 0; j < 4; ++j) { v0[j] = siluf_(v0[j]); v1[j] = siluf_(v1[j]); }
        } else if (act == 2) {
#pragma unroll
            for (int j = 0; j < 4; ++j) { v0[j] = sigmoidf_(v0[j]); v1[j] = sigmoidf_(v1[j]); }
        } else { v0 = v0 * sc; v1 = v1 * sc; }
        *(u32x4*)dst = pack8(v0, v1);
    }
};
struct EpiProjA {
    const bf16* gd; bf16* T;
    __device__ __forceinline__ void chunk(const Unit& u, int r, int c, f32x4 v0, f32x4 v1) const {
        const size_t o = (size_t)(u.pm * 256 + r) * 1024 + u.pn * 256 + c;
        f32x4 g0, g1; unpack8(*(const u32x4*)(gd + o), g0, g1);
        *(u32x4*)(T + o) = pack8(v0 * g0, v1 * g1);
    }
};
struct EpiProjG {
    const bf16* ga; const bf16* T; bf16* merged;
    __device__ __forceinline__ void chunk(const Unit& u, int r, int c, f32x4 v0, f32x4 v1) const {
        const size_t o = (size_t)(u.pm * 256 + r) * 1024 + u.pn * 256 + c;
        f32x4 g0, g1, t0, t1; unpack8(*(const u32x4*)(ga + o), g0, g1); unpack8(*(const u32x4*)(T + o), t0, t1);
        *(u32x4*)(merged + o) = pack8(v0 * g0 + t0, v1 * g1 + t1);
    }
};
struct EpiOut {
    const float* x; const float* mods; float* t1;
    __device__ __forceinline__ void chunk(const Unit& u, int r, int c, f32x4 v0, f32x4 v1) const {
        const int row = u.pm * 256 + r, col = u.pn * 256 + c, b = row >> 12;
        const size_t o = (size_t)row * 1024 + col;
        const float* g = mods + b * 6144 + 2 * 1024 + col;
        const f32x4 x0 = *(const f32x4*)(x + o), x1 = *(const f32x4*)(x + o + 4), g0 = *(const f32x4*)g, g1v = *(const f32x4*)(g + 4);
        *(f32x4*)(t1 + o) = x0 * ALPHA + g0 * v0; *(f32x4*)(t1 + o + 4) = x1 * ALPHA + g1v * v1;
    }
};
struct EpiMoeUp {
    bf16* H;
    __device__ __forceinline__ void chunk(const Unit& u, int r, int c, f32x4 v0, f32x4 v1) const {
        const size_t row = (size_t)u.pm * 256 + r; const int f = ((u.pn * 256 + c) >> 3) * 4;
        u32x2 w; w.x = pk2(siluf_(v0[0]) * v1[0], siluf_(v0[1]) * v1[1]); w.y = pk2(siluf_(v0[2]) * v1[2], siluf_(v0[3]) * v1[3]);
        *(u32x2*)(H + row * 512 + f) = w;
    }
};
struct EpiMoeDown {
    const unsigned* cnt; const unsigned* lst; const float* lstw; bf16* Y;
    __device__ __forceinline__ void chunk(const Unit& u, int r, int c, f32x4 v0, f32x4 v1) const {
        const unsigned pos = (unsigned)(u.mt * 256 + r);
        if (pos < cnt[u.e * CNT_STRIDE]) {
            const unsigned ent = lst[(size_t)u.e * NTOK + pos]; const float w = lstw[(size_t)u.e * NTOK + pos];
            bf16* dst = Y + ((size_t)(ent & 1u) * NTOK + (ent >> 1)) * 1024 + u.pn * 256 + c;
            *(u32x4*)dst = pack8(v0 * w, v1 * w);
        }
    }
};
struct MoeOrder {
    static constexpr bool GATHER = true;
    const LAS int* ts; const unsigned* cnt; const unsigned* lst; int G, c, mode;
    __device__ __forceinline__ bool next(int i, Unit& u) const {
        const int L = i * G + c, ntile = ts[32]; if (L >= 4 * ntile) return false;
        const int T = L >> 2; int e = 0;
        for (int j = 1; j < 32; ++j) e += (ts[j] <= T) ? 1 : 0;
        u.pm = T; u.pn = L & 3; u.e = e; u.mt = T - ts[e]; return true;
    }
    __device__ __forceinline__ size_t a_base(const Unit& u) const { return mode == 0 ? (size_t)0 : (size_t)u.pm * 256 * 1024; }
    __device__ __forceinline__ unsigned a_lane(const Unit& u, int r) const {
        if (mode == 0) { unsigned pos = (unsigned)(u.mt * 256 + r); if (pos >= cnt[u.e * CNT_STRIDE]) pos = 0; return (lst[(size_t)u.e * NTOK + pos] >> 1) * 2048u; }
        return (unsigned)r * 1024u;
    }
    __device__ __forceinline__ size_t b_off(const Unit& u) const {
        return mode == 0 ? ((size_t)u.e * 1024 + (size_t)u.pn * 256) * 1024 * 2 : ((size_t)u.e * 1024 + (size_t)u.pn * 256) * 512 * 2;
    }
};

struct MapWin { __device__ __forceinline__ int operator()(int n) const { return n < 3072 ? n : (n < 3088 ? C_LR + (n - 3072) : n - 16); } };
struct MapId { __device__ __forceinline__ int operator()(int n) const { return n; } };
struct MapGate { __device__ __forceinline__ int operator()(int f) const { return (f >> 2) * 8 + (f & 3); } };
struct MapUp { __device__ __forceinline__ int operator()(int f) const { return (f >> 2) * 8 + 4 + (f & 3); } };
template <class RowMap>
__device__ __forceinline__ void transpose_item(const float* W, int K, int N, bf16* WT, LAS float* scr, int item, int lane, RowMap rm) {
    const int nblk = (N + 31) / 32, kb = item / nblk, nb = item % nblk, k0 = 64 * kb, n0 = 32 * nb;
    const int kr = lane >> 3, nq = (lane & 7) * 4; const bool ok = (n0 + nq) < N;
    f32x4 v[8];
#pragma unroll
    for (int i = 0; i < 8; ++i) v[i] = ok ? *(const f32x4*)(W + (size_t)(k0 + 8 * i + kr) * N + n0 + nq) : (f32x4){0.f, 0.f, 0.f, 0.f};
#pragma unroll
    for (int i = 0; i < 8; ++i) { LAS float* d = scr + (8 * i + kr) * 33 + nq; d[0] = v[i][0]; d[1] = v[i][1]; d[2] = v[i][2]; d[3] = v[i][3]; }
    LDS_WAIT(); asm volatile("" ::: "memory");
    const int c = lane & 7;
#pragma unroll
    for (int j = 0; j < 4; ++j) { const int n = (lane >> 3) + 8 * j; const LAS float* s = scr + (8 * c) * 33 + n;
        u32x4 o; o.x = pk2(s[0 * 33], s[1 * 33]); o.y = pk2(s[2 * 33], s[3 * 33]); o.z = pk2(s[4 * 33], s[5 * 33]); o.w = pk2(s[6 * 33], s[7 * 33]);
        if (n0 + n < N) *(u32x4*)(WT + (size_t)rm(n0 + n) * K + k0 + 8 * c) = o; }
    LDS_WAIT(); asm volatile("" ::: "memory");
}
__device__ __forceinline__ int t5_bucket(int dist) {
    if (dist < 16) return dist;
    int large = 16 + (int)(log((double)dist / 16.0) / log(128.0) * 16.0);
    return large < 31 ? large : 31;
}
__device__ __forceinline__ void p0_phase(Frame& F, const Args& args) {
    LAS float* scr = (LAS float*)(F.lds + F.wave * 16384);
    LAS f32x4* sc = (LAS f32x4*)(F.lds + 131072);
    const float* c = args.in[1];
    for (int k = F.tid; k < 1024; k += NTHR) sc[k] = (f32x4){siluf_(c[k]), siluf_(c[1024 + k]), siluf_(c[2048 + k]), siluf_(c[3072 + k])};
    __syncthreads();
    const int gw = F.vcu * NWAVES + F.wave, NGW = F.G * NWAVES, lane = F.lane;
    float* mods = (float*)(F.ws + WS_MODS);
#pragma unroll 1
    for (int it = gw; it < 384; it += NGW) {
        const int col = it * 16 + (lane & 15), kq = lane >> 4; const float* w = args.in[3] + col;
        float a0 = 0.f, a1 = 0.f, a2 = 0.f, a3 = 0.f;
#pragma unroll 32
        for (int k = kq; k < 1024; k += 4) { const float wv = w[(size_t)k * 6144]; const f32x4 s = sc[k]; a0 += s.x * wv; a1 += s.y * wv; a2 += s.z * wv; a3 += s.w * wv; }
        a0 += __shfl_xor(a0, 16); a0 += __shfl_xor(a0, 32); a1 += __shfl_xor(a1, 16); a1 += __shfl_xor(a1, 32);
        a2 += __shfl_xor(a2, 16); a2 += __shfl_xor(a2, 32); a3 += __shfl_xor(a3, 16); a3 += __shfl_xor(a3, 32);
        if (lane < 16) { const float bb = args.in[4][col]; mods[col] = a0 + bb; mods[6144 + col] = a1 + bb; mods[2 * 6144 + col] = a2 + bb; mods[3 * 6144 + col] = a3 + bb; }
    }
    if (gw == NGW - 1) {
        float* bt = (float*)(F.ws + WS_BTAB);
        for (int i = lane; i < 24 * 129; i += 64) { const int h = i / 129, m = i % 129, dil = (h < 8) ? 1 : (h < 16 ? 4 : 16); bt[h * 132 + m] = args.in[2][t5_bucket(m * dil) * 24 + h]; }
    }
    constexpr int I_IN = 16 * 305, I_PG = 16 * 32, I_PA = 8 * 32, I_OUT = 16 * 32, I_PAD = 240, I_WR = 48;
    constexpr int NIT = I_IN + I_PG + I_PA + I_OUT + I_PAD + I_WR;
#pragma unroll 1
    for (int it = gw; it < NIT; it += NGW) {
        int r = it;
        if (r < I_IN) { transpose_item(args.in[5], 1024, INCOLS, (bf16*)(F.ws + WS_WIN), scr, r, lane, MapWin()); continue; } r -= I_IN;
        if (r < I_PG) { transpose_item(args.in[9], 1024, 1024, (bf16*)(F.ws + WS_WPG), scr, r, lane, MapId()); continue; } r -= I_PG;
        if (r < I_PA) { transpose_item(args.in[10], 512, 1024, (bf16*)(F.ws + WS_WPA), scr, r, lane, MapId()); continue; } r -= I_PA;
        if (r < I_OUT) { transpose_item(args.in[11], 1024, 1024, (bf16*)(F.ws + WS_WOUT), scr, r, lane, MapId()); continue; } r -= I_OUT;
        if (r < I_PAD) { u32x4* z = (u32x4*)((bf16*)(F.ws + WS_WIN) + (size_t)(INCOLS + r) * 1024); z[lane] = (u32x4){0u, 0u, 0u, 0u}; z[64 + lane] = (u32x4){0u, 0u, 0u, 0u}; continue; } r -= I_PAD;
        {
            bf16* hi_ = (bf16*)(F.ws + WS_WRT) + (size_t)r * 1024; bf16* lo_ = hi_ + 48 * 1024;
            for (int k = lane; k < 1024; k += 64) { const float v = (r < 4) ? args.in[14][k * 4 + r] : (r < 36 ? args.in[16][k * 32 + r - 4] : 0.f);
                const bf16 h = f2bf(v); hi_[k] = h; lo_[k] = f2bf(v - bf2f(h)); }
        }
    }
}
__device__ __forceinline__ void convert_experts(Frame& F, const Args& args) {
    LAS float* scr = (LAS float*)(F.lds + F.wave * 16384);
    const int gw = F.vcu * NWAVES + F.wave, NGW = F.G * NWAVES, lane = F.lane;
    bf16* wgu = (bf16*)(F.ws + WS_WGU); bf16* wdn = (bf16*)(F.ws + WS_WDN);
#pragma unroll 1
    for (int it = gw; it < 3 * 8192; it += NGW) {
        const int kind = it >> 13, r = it & 8191, e = r >> 8, sub = r & 255;
        if (kind == 0) transpose_item(args.in[18] + (size_t)e * 1024 * 512, 1024, 512, wgu + (size_t)e * 1024 * 1024, scr, sub, lane, MapGate());
        else if (kind == 1) transpose_item(args.in[19] + (size_t)e * 1024 * 512, 1024, 512, wgu + (size_t)e * 1024 * 1024, scr, sub, lane, MapUp());
        else transpose_item(args.in[20] + (size_t)e * 512 * 1024, 512, 1024, wdn + (size_t)e * 1024 * 512, scr, sub, lane, MapId());
    }
}
__device__ __forceinline__ void p0b_phase(Frame& F, const Args& args) {
    const int gw = F.vcu * NWAVES + F.wave, NGW = F.G * NWAVES, lane = F.lane;
    const float* mods = (const float*)(F.ws + WS_MODS); bf16* U = (bf16*)(F.ws + WS_U);
#pragma unroll 1
    for (int m = gw; m < NTOK; m += NGW) {
        const int b = m >> 12; const f32x4* xr = (const f32x4*)(args.in[0] + (size_t)m * 1024) + lane;
        const f32x4* sh = (const f32x4*)(mods + b * 6144) + lane; const f32x4* sc = (const f32x4*)(mods + b * 6144 + 1024) + lane;
        u32x2* o = (u32x2*)(U + (size_t)m * 1024) + lane;
#pragma unroll
        for (int j = 0; j < 4; ++j) { const f32x4 v = xr[64 * j] * (sc[64 * j] + 1.f) + sh[64 * j]; u32x2 w; w.x = pk2(v[0], v[1]); w.y = pk2(v[2], v[3]); o[64 * j] = w; }
    }
}

__device__ __forceinline__ s16x4 tr_read(const LAS unsigned char* p) {
    typedef short v4i16_t __attribute__((ext_vector_type(4)));
    return __builtin_bit_cast(s16x4, __builtin_amdgcn_ds_read_tr16_b64_v4i16((LAS v4i16_t*)p));
}
__device__ __forceinline__ void attn_phase(Frame& F) {
    const int tid = F.tid, lane = F.lane, wid = F.wave, half = wid >> 2, w4 = wid & 3, l31 = lane & 31, hi = lane >> 5;
    LAS unsigned char* Kl = F.lds + half * 36864;
    LAS unsigned char* Vl = F.lds + 73728 + half * 36864;
    LAS float* bl = (LAS float*)(F.lds + 147456) + half * 192;
    bf16* QD = (bf16*)(F.ws + WS_QD); const bf16* KD = (const bf16*)(F.ws + WS_KD); const bf16* VD = (const bf16*)(F.ws + WS_VD);
    float* LSE = (float*)(F.ws + WS_LSE); const float* BT = (const float*)(F.ws + WS_BTAB);
#pragma unroll 1
    for (int it = 0;; ++it) {
        const int L = it * F.G + F.vcu; if (L >= 1536) break;
        const int g = L >> 9, wq = L & 511, b = wq >> 7, w2 = wq & 127, hp = w2 >> 5, w3 = w2 & 31;
        const int dsh = 2 * g, dil = 1 << dsh, nblk = 32 >> dsh, r = w3 / nblk, nb = w3 % nblk;
        const int head = 2 * hp + half, colb = g * 512 + head * 64;
        __syncthreads();
        {
            const int t = tid & 255, ch = t & 7;
#pragma unroll
            for (int p = 0; p < 8; ++p) {
                const int row = p * 32 + (t >> 3), lidx = nb * 128 - 128 + row;
                u32x4 kv = (u32x4){0u, 0u, 0u, 0u}, vv = kv;
                if (lidx >= 0) { const size_t o = (size_t)(b * SEQ + lidx * dil + r) * 1536 + colb + ch * 8; kv = *(const u32x4*)(KD + o); vv = *(const u32x4*)(VD + o); }
                *(LAS u32x4*)(Kl + row * 144 + ch * 16) = kv; *(LAS u32x4*)(Vl + row * 144 + ch * 16) = vv;
            }
            if (t < 192) bl[t] = (t >= 32 && t <= 160) ? BT[(g * 8 + head) * 132 + t - 32] : 0.f;
        }
        const int qi = 32 * w4 + l31; const size_t qtok = (size_t)(b * SEQ + (nb * 128 + qi) * dil + r);
        bf16x8 qf[4];
#pragma unroll
        for (int kk = 0; kk < 4; ++kk) qf[kk] = *(const bf16x8*)(QD + qtok * 1536 + colb + kk * 16 + hi * 8);
        __syncthreads();
        f32x16 sa[5]; float mx = -INFINITY;
        const int mb = l31 + 128 - 4 * hi;
        const LAS float* blq = bl + (mb - 123);
        const unsigned mlim = (nb > 0) ? 128u : (unsigned)(qi < 128 ? qi : 128);
#pragma unroll
        for (int t = 0; t < 5; ++t) {
            const int kt = w4 + t; const bool act = (nb > 0) || (kt >= 4);
            f32x16 a = {0.f, 0.f, 0.f, 0.f, 0.f, 0.f, 0.f, 0.f, 0.f, 0.f, 0.f, 0.f, 0.f, 0.f, 0.f, 0.f};
            if (act) {
                const LAS unsigned char* kp = Kl + (32 * kt + l31) * 144 + hi * 16;
#pragma unroll
                for (int kk = 0; kk < 4; ++kk) { const bf16x8 kf = *(const LAS bf16x8*)(kp + kk * 32); a = __builtin_amdgcn_mfma_f32_32x32x16_bf16(kf, qf[kk], a, 0, 0, 0); }
            }
#pragma unroll
            for (int rr = 0; rr < 16; ++rr) {
                const int cc = 32 * t + (rr & 3) + 8 * (rr >> 2);
                const unsigned m = (unsigned)(mb - cc);
                float s = a[rr] + blq[155 - cc];
                s = (m <= mlim) ? s : -INFINITY;
                a[rr] = s; mx = fmaxf(mx, s);
            }
            sa[t] = a;
        }
        mx = fmaxf(mx, __shfl_xor(mx, 32));
        float sum = 0.f;
#pragma unroll
        for (int t = 0; t < 5; ++t)
#pragma unroll
            for (int rr = 0; rr < 16; ++rr) { const float p = __expf(sa[t][rr] - mx); sa[t][rr] = p; sum += p; }
        sum += __shfl_xor(sum, 32);
        f32x16 o0 = {0.f, 0.f, 0.f, 0.f, 0.f, 0.f, 0.f, 0.f, 0.f, 0.f, 0.f, 0.f, 0.f, 0.f, 0.f, 0.f}, o1 = o0;
        const int i16 = lane & 15, g2 = (lane >> 4) & 1;
        const LAS unsigned char* vbase = Vl + (4 * hi + (i16 >> 2)) * 144 + (16 * g2 + 4 * (i16 & 3)) * 2;
#pragma unroll
        for (int t = 0; t < 5; ++t) {
            const int kt = w4 + t; const bool act = (nb > 0) || (kt >= 4);
            if (act) {
#pragma unroll
                for (int s2 = 0; s2 < 2; ++s2) {
                    u32x4 pw; pw.x = pk2(sa[t][8 * s2 + 0], sa[t][8 * s2 + 1]); pw.y = pk2(sa[t][8 * s2 + 2], sa[t][8 * s2 + 3]); pw.z = pk2(sa[t][8 * s2 + 4], sa[t][8 * s2 + 5]); pw.w = pk2(sa[t][8 * s2 + 6], sa[t][8 * s2 + 7]);
                    const bf16x8 pf = __builtin_bit_cast(bf16x8, pw);
                    const LAS unsigned char* vp = vbase + (32 * kt + 16 * s2) * 144;
                    const s16x4 a0 = tr_read(vp), a1 = tr_read(vp + 8 * 144), c0 = tr_read(vp + 64), c1 = tr_read(vp + 8 * 144 + 64);
                    const bf16x8 vf0 = (bf16x8){a0[0], a0[1], a0[2], a0[3], a1[0], a1[1], a1[2], a1[3]};
                    const bf16x8 vf1 = (bf16x8){c0[0], c0[1], c0[2], c0[3], c1[0], c1[1], c1[2], c1[3]};
                    o0 = __builtin_amdgcn_mfma_f32_32x32x16_bf16(vf0, pf, o0, 0, 0, 0);
                    o1 = __builtin_amdgcn_mfma_f32_32x32x16_bf16(vf1, pf, o1, 0, 0, 0);
                }
            }
        }
        const float inv = 1.f / sum;
        bf16* orow = QD + qtok * 1536 + colb;
#pragma unroll
        for (int a4 = 0; a4 < 4; ++a4) {
            u32x2 w0, w1;
            w0.x = pk2(o0[4 * a4] * inv, o0[4 * a4 + 1] * inv); w0.y = pk2(o0[4 * a4 + 2] * inv, o0[4 * a4 + 3] * inv);
            w1.x = pk2(o1[4 * a4] * inv, o1[4 * a4 + 1] * inv); w1.y = pk2(o1[4 * a4 + 2] * inv, o1[4 * a4 + 3] * inv);
            *(u32x2*)(orow + 8 * a4 + 4 * hi) = w0; *(u32x2*)(orow + 32 + 8 * a4 + 4 * hi) = w1;
        }
        if (hi == 0) LSE[qtok * 24 + g * 8 + head] = mx + __logf(sum);
    }
    __syncthreads();
}
__device__ __forceinline__ void combine_phase(Frame& F) {
    const int gw = F.vcu * NWAVES + F.wave, NGW = F.G * NWAVES, lane = F.lane, hh = lane >> 3, ch = lane & 7;
    const bf16* OG = (const bf16*)(F.ws + WS_QD); const float* LSE = (const float*)(F.ws + WS_LSE); bf16* YA = (bf16*)(F.ws + WS_YATT);
#pragma unroll 1
    for (int m = gw; m < NTOK; m += NGW) {
        const float l0 = LSE[(size_t)m * 24 + hh], l1 = LSE[(size_t)m * 24 + 8 + hh], l2 = LSE[(size_t)m * 24 + 16 + hh];
        const float mm = fmaxf(l0, fmaxf(l1, l2)); float e0 = __expf(l0 - mm), e1 = __expf(l1 - mm), e2 = __expf(l2 - mm); const float is = 1.f / (e0 + e1 + e2);
        e0 *= is; e1 *= is; e2 *= is;
        const bf16* o = OG + (size_t)m * 1536 + hh * 64 + ch * 8;
        f32x4 a0, a1, b0, b1, c0, c1; unpack8(*(const u32x4*)o, a0, a1); unpack8(*(const u32x4*)(o + 512), b0, b1); unpack8(*(const u32x4*)(o + 1024), c0, c1);
        *(u32x4*)(YA + (size_t)m * 512 + hh * 64 + ch * 8) = pack8(a0 * e0 + b0 * e1 + c0 * e2, a1 * e0 + b1 * e1 + c1 * e2);
    }
}

constexpr int GA_LB = 0, GA_QT = 33792, GA_KT = 51200, GA_KH = 68608, GA_VT = 87040, GA_AT = 123904, GA_LR = 133120, GA_WG = 137216, GA_BG = 145408, GA_QS = 145920;
__device__ __forceinline__ float log_sigmoid_(float x) { return fminf(x, 0.f) - __logf(1.f + __expf(-fabsf(x))); }
__device__ __forceinline__ void gla_a_phase(Frame& F, const Args& args) {
    const int tid = F.tid, lane = F.lane, wid = F.wave, l31 = lane & 31, hi = lane >> 5;
    LAS unsigned char* lds = F.lds;
    LAS float* LB = (LAS float*)(lds + GA_LB); LAS float* LRs = (LAS float*)(lds + GA_LR); LAS float* QS = (LAS float*)(lds + GA_QS);
    bf16* QA = (bf16*)(F.ws + WS_QA); const bf16* KA = (const bf16*)(F.ws + WS_KA); bf16* VA = (bf16*)(F.ws + WS_VA);
    const float* LR = (const float*)(F.ws + WS_LR); bf16* DS = (bf16*)(F.ws + WS_DS); float* DEC = (float*)(F.ws + WS_DECAY);
    if (F.vcu >= 1024) return;
    const int h0 = (F.vcu >> 6) & 3, kcol = tid & 127, tq = tid >> 7;
    float wg[16];
#pragma unroll
    for (int j = 0; j < 16; ++j) wg[j] = args.in[6][j * 512 + h0 * 128 + kcol];
    const float bg = args.in[7][h0 * 128 + kcol];
    u32x4 pq[2], pk[2], pv[4]; f32x4 plr = {0.f, 0.f, 0.f, 0.f};
#define GLA_PREFETCH(UU) do { const int bh_ = (UU) >> 6, c_ = (UU) & 63; const size_t tk_ = (size_t)(bh_ >> 2) * SEQ + c_ * 64 + lane; const int h_ = bh_ & 3; \
        _Pragma("unroll") for (int p = 0; p < 2; ++p) { pq[p] = *(const u32x4*)(QA + tk_ * 512 + h_ * 128 + (wid * 2 + p) * 8); pk[p] = *(const u32x4*)(KA + tk_ * 512 + h_ * 128 + (wid * 2 + p) * 8); } \
        _Pragma("unroll") for (int p = 0; p < 4; ++p) pv[p] = *(const u32x4*)(VA + tk_ * 1024 + h_ * 256 + (wid * 4 + p) * 8); \
        if (tid < 256) plr = *(const f32x4*)(LR + ((size_t)(bh_ >> 2) * SEQ + c_ * 64) * 16 + tid * 4); } while (0)
    GLA_PREFETCH(F.vcu);
#pragma unroll 1
    for (int it = 0;; ++it) {
        const int U = it * F.G + F.vcu; if (U >= 1024) break;
        const int bh = U >> 6, c = U & 63, b = bh >> 2, h = bh & 3; const size_t tok0 = (size_t)b * SEQ + c * 64;
        __syncthreads();
        if (tid < 256) *(LAS f32x4*)(LRs + tid * 4) = plr;
        __syncthreads();
        {
            const int k = kcol; float cs = 0.f;
#pragma unroll 4
            for (int tt = 0; tt < 16; ++tt) { const int t = tq * 16 + tt; float lg = bg;
#pragma unroll
                for (int j4 = 0; j4 < 4; ++j4) { const f32x4 l4 = *(const LAS f32x4*)(LRs + t * 16 + j4 * 4); lg += l4[0] * wg[4 * j4] + l4[1] * wg[4 * j4 + 1] + l4[2] * wg[4 * j4 + 2] + l4[3] * wg[4 * j4 + 3]; }
                cs += log_sigmoid_(lg) * (1.f / 16.f); LB[t * 132 + k] = cs; }
            QS[tq * 128 + k] = cs;
            __syncthreads();
            float off = 0.f;
#pragma unroll
            for (int q = 0; q < 3; ++q) off += (q < tq) ? QS[q * 128 + k] : 0.f;
            if (tq > 0) {
#pragma unroll 4
                for (int tt = 0; tt < 16; ++tt) LB[(tq * 16 + tt) * 132 + k] += off;
            }
        }
        __syncthreads();
        {
            const int t = lane; const size_t tok = tok0 + t;
#pragma unroll
            for (int p = 0; p < 2; ++p) {
                const int kc = wid * 2 + p;
                f32x4 q0, q1, k0, k1; unpack8(pq[p], q0, q1); unpack8(pk[p], k0, k1);
                const f32x4 b0 = *(const LAS f32x4*)(LB + t * 132 + kc * 8), b1 = *(const LAS f32x4*)(LB + t * 132 + kc * 8 + 4);
                const f32x4 e0 = *(const LAS f32x4*)(LB + 63 * 132 + kc * 8), e1 = *(const LAS f32x4*)(LB + 63 * 132 + kc * 8 + 4);
                f32x4 qt0, qt1, kt0, kt1, kh0, kh1;
#pragma unroll
                for (int j = 0; j < 4; ++j) {
                    qt0[j] = q0[j] * __expf(b0[j]); qt1[j] = q1[j] * __expf(b1[j]);
                    kt0[j] = k0[j] * __expf(-b0[j]); kt1[j] = k1[j] * __expf(-b1[j]);
                    kh0[j] = k0[j] * __expf(e0[j] - b0[j]); kh1[j] = k1[j] * __expf(e1[j] - b1[j]);
                }
                const u32x4 qw = pack8(qt0, qt1);
                *(LAS u32x4*)(lds + GA_QT + t * 272 + kc * 16) = qw; *(u32x4*)(QA + tok * 512 + h * 128 + kc * 8) = qw;
                *(LAS u32x4*)(lds + GA_KT + t * 272 + kc * 16) = pack8(kt0, kt1);
#pragma unroll
                for (int j = 0; j < 4; ++j) { *(LAS bf16*)(lds + GA_KH + (kc * 8 + j) * 144 + t * 2) = f2bf(kh0[j]); *(LAS bf16*)(lds + GA_KH + (kc * 8 + 4 + j) * 144 + t * 2) = f2bf(kh1[j]); }
            }
#pragma unroll
            for (int p = 0; p < 4; ++p) {
                const int vc = wid * 4 + p; const u32x4 vv = pv[p];
                const unsigned w[4] = {vv.x, vv.y, vv.z, vv.w};
#pragma unroll
                for (int j = 0; j < 4; ++j) { *(LAS bf16*)(lds + GA_VT + (vc * 8 + 2 * j) * 144 + t * 2) = (bf16)(w[j] & 0xffffu); *(LAS bf16*)(lds + GA_VT + (vc * 8 + 2 * j + 1) * 144 + t * 2) = (bf16)(w[j] >> 16); }
            }
            if (tid < 128) DEC[(size_t)U * 128 + tid] = __expf(LB[63 * 132 + tid]);
        }
        { const int Un = U + F.G; if (Un < 1024) GLA_PREFETCH(Un); }
        __syncthreads();
        if (wid < 4) {
            const int mt = wid >> 1, nt = wid & 1;
            f32x16 a = {0.f, 0.f, 0.f, 0.f, 0.f, 0.f, 0.f, 0.f, 0.f, 0.f, 0.f, 0.f, 0.f, 0.f, 0.f, 0.f};
#pragma unroll
            for (int kk = 0; kk < 8; ++kk) {
                const bf16x8 qf = *(const LAS bf16x8*)(lds + GA_QT + (32 * mt + l31) * 272 + kk * 32 + hi * 16);
                const bf16x8 kf = *(const LAS bf16x8*)(lds + GA_KT + (32 * nt + l31) * 272 + kk * 32 + hi * 16);
                a = __builtin_amdgcn_mfma_f32_32x32x16_bf16(qf, kf, a, 0, 0, 0);
            }
            const int s = 32 * nt + l31;
#pragma unroll
            for (int rr = 0; rr < 16; ++rr) { const int t = 32 * mt + crow(rr, hi); *(LAS bf16*)(lds + GA_AT + t * 144 + s * 2) = f2bf(t >= s ? a[rr] : 0.f); }
        }
        __syncthreads();
        {
            f32x16 a0 = {0.f, 0.f, 0.f, 0.f, 0.f, 0.f, 0.f, 0.f, 0.f, 0.f, 0.f, 0.f, 0.f, 0.f, 0.f, 0.f}, a1 = a0;
#pragma unroll
            for (int ks = 0; ks < 4; ++ks) {
                const bf16x8 vf = *(const LAS bf16x8*)(lds + GA_VT + (32 * wid + l31) * 144 + ks * 32 + hi * 16);
                const bf16x8 t0 = *(const LAS bf16x8*)(lds + GA_AT + l31 * 144 + ks * 32 + hi * 16);
                const bf16x8 t1 = *(const LAS bf16x8*)(lds + GA_AT + (32 + l31) * 144 + ks * 32 + hi * 16);
                a0 = __builtin_amdgcn_mfma_f32_32x32x16_bf16(vf, t0, a0, 0, 0, 0);
                a1 = __builtin_amdgcn_mfma_f32_32x32x16_bf16(vf, t1, a1, 0, 0, 0);
            }
            bf16* o0 = VA + (tok0 + l31) * 1024 + h * 256 + 32 * wid + 4 * hi; bf16* o1 = o0 + 32 * 1024;
#pragma unroll
            for (int a4 = 0; a4 < 4; ++a4) {
                u32x2 w0, w1; w0.x = pk2(a0[4 * a4], a0[4 * a4 + 1]); w0.y = pk2(a0[4 * a4 + 2], a0[4 * a4 + 3]); w1.x = pk2(a1[4 * a4], a1[4 * a4 + 1]); w1.y = pk2(a1[4 * a4 + 2], a1[4 * a4 + 3]);
                *(u32x2*)(o0 + 8 * a4) = w0; *(u32x2*)(o1 + 8 * a4) = w1;
            }
        }
        {
            f32x16 a[4];
#pragma unroll
            for (int mt = 0; mt < 4; ++mt) a[mt] = (f32x16){0.f, 0.f, 0.f, 0.f, 0.f, 0.f, 0.f, 0.f, 0.f, 0.f, 0.f, 0.f, 0.f, 0.f, 0.f, 0.f};
#pragma unroll
            for (int ks = 0; ks < 4; ++ks) {
                const bf16x8 vf = *(const LAS bf16x8*)(lds + GA_VT + (32 * wid + l31) * 144 + ks * 32 + hi * 16);
#pragma unroll
                for (int mt = 0; mt < 4; ++mt) { const bf16x8 kf = *(const LAS bf16x8*)(lds + GA_KH + (32 * mt + l31) * 144 + ks * 32 + hi * 16); a[mt] = __builtin_amdgcn_mfma_f32_32x32x16_bf16(kf, vf, a[mt], 0, 0, 0); }
            }
            bf16* d = DS + (size_t)U * 32768 + (size_t)(32 * wid + l31) * 128 + 4 * hi;
#pragma unroll
            for (int mt = 0; mt < 4; ++mt)
#pragma unroll
                for (int a4 = 0; a4 < 4; ++a4) { u32x2 w; w.x = pk2(a[mt][4 * a4], a[mt][4 * a4 + 1]); w.y = pk2(a[mt][4 * a4 + 2], a[mt][4 * a4 + 3]); *(u32x2*)(d + 32 * mt + 8 * a4) = w; }
        }
    }
#undef GLA_PREFETCH
    __syncthreads();
}
__device__ __forceinline__ void gla_scan_phase(Frame& F) {
    bf16* DS = (bf16*)(F.ws + WS_DS); const float* DEC = (const float*)(F.ws + WS_DECAY);
#pragma unroll 1
    for (int e4 = F.vcu * NTHR + F.tid; e4 < 16 * 8192; e4 += F.G * NTHR) {
        const int bh = e4 >> 13, rem = e4 & 8191; const size_t eo = (size_t)(rem >> 5) * 128 + (rem & 31) * 4;
        f32x4 s = {0.f, 0.f, 0.f, 0.f};
#pragma unroll 8
        for (int c = 0; c < 64; ++c) {
            const size_t U = (size_t)bh * 64 + c; u32x2* p = (u32x2*)(DS + U * 32768 + eo);
            const u32x2 w = *p; const f32x4 dc = *(const f32x4*)(DEC + U * 128 + (rem & 31) * 4);
            u32x2 o; o.x = pk2(s[0], s[1]); o.y = pk2(s[2], s[3]); *p = o;
            s[0] = s[0] * dc[0] + bflo(w.x); s[1] = s[1] * dc[1] + bfhi(w.x); s[2] = s[2] * dc[2] + bflo(w.y); s[3] = s[3] * dc[3] + bfhi(w.y);
        }
    }
}
__device__ __forceinline__ void gla_c_phase(Frame& F, const Args& args) {
    const int tid = F.tid, lane = F.lane, wid = F.wave, l31 = lane & 31, hi = lane >> 5;
    LAS unsigned char* lds = F.lds; LAS float* SS = (LAS float*)(lds + 20480);
    const bf16* QA = (const bf16*)(F.ws + WS_QA); const bf16* OI = (const bf16*)(F.ws + WS_VA); const bf16* RA = (const bf16*)(F.ws + WS_RA);
    const bf16* DS = (const bf16*)(F.ws + WS_DS); bf16* YG = (bf16*)(F.ws + WS_YGLA);
#pragma unroll 1
    for (int it = 0;; ++it) {
        const int U = it * F.G + F.vcu; if (U >= 1024) break;
        const int bh = U >> 6, c = U & 63, b = bh >> 2, h = bh & 3; const size_t tok0 = (size_t)b * SEQ + c * 64;
        __syncthreads();
#pragma unroll
        for (int p = 0; p < 2; ++p) { const int ch = tid + p * NTHR, t = ch >> 4, kc = ch & 15; *(LAS u32x4*)(lds + t * 272 + kc * 16) = *(const u32x4*)(QA + (tok0 + t) * 512 + h * 128 + kc * 8); }
        __syncthreads();
        f32x16 a0 = {0.f, 0.f, 0.f, 0.f, 0.f, 0.f, 0.f, 0.f, 0.f, 0.f, 0.f, 0.f, 0.f, 0.f, 0.f, 0.f}, a1 = a0;
        const bf16* srow = DS + (size_t)U * 32768 + (size_t)(32 * wid + l31) * 128 + hi * 8;
#pragma unroll
        for (int kk = 0; kk < 8; ++kk) {
            const bf16x8 sf = *(const bf16x8*)(srow + kk * 16);
            const bf16x8 q0 = *(const LAS bf16x8*)(lds + l31 * 272 + kk * 32 + hi * 16);
            const bf16x8 q1 = *(const LAS bf16x8*)(lds + (32 + l31) * 272 + kk * 32 + hi * 16);
            a0 = __builtin_amdgcn_mfma_f32_32x32x16_bf16(sf, q0, a0, 0, 0, 0);
            a1 = __builtin_amdgcn_mfma_f32_32x32x16_bf16(sf, q1, a1, 0, 0, 0);
        }
        const size_t e0 = (tok0 + l31) * 1024 + h * 256 + 32 * wid + 4 * hi, e1 = e0 + 32 * 1024;
        float q0s = 0.f, q1s = 0.f;
#pragma unroll
        for (int a4 = 0; a4 < 4; ++a4) {
            const u32x2 w0 = *(const u32x2*)(OI + e0 + 8 * a4), w1 = *(const u32x2*)(OI + e1 + 8 * a4);
            a0[4 * a4] += bflo(w0.x); a0[4 * a4 + 1] += bfhi(w0.x); a0[4 * a4 + 2] += bflo(w0.y); a0[4 * a4 + 3] += bfhi(w0.y);
            a1[4 * a4] += bflo(w1.x); a1[4 * a4 + 1] += bfhi(w1.x); a1[4 * a4 + 2] += bflo(w1.y); a1[4 * a4 + 3] += bfhi(w1.y);
#pragma unroll
            for (int j = 0; j < 4; ++j) { q0s += a0[4 * a4 + j] * a0[4 * a4 + j]; q1s += a1[4 * a4 + j] * a1[4 * a4 + j]; }
        }
        q0s += __shfl_xor(q0s, 32); q1s += __shfl_xor(q1s, 32);
        if (hi == 0) { SS[wid * 64 + l31] = q0s; SS[wid * 64 + 32 + l31] = q1s; }
        __syncthreads();
        float t0 = 0.f, t1 = 0.f;
#pragma unroll
        for (int w = 0; w < 8; ++w) { t0 += SS[w * 64 + l31]; t1 += SS[w * 64 + 32 + l31]; }
        const float r0 = rsqrtf(t0 * (1.f / 256.f) + LN_EPS), r1 = rsqrtf(t1 * (1.f / 256.f) + LN_EPS);
        const float* ng = args.in[8] + h * 256 + 32 * wid + 4 * hi;
#pragma unroll
        for (int a4 = 0; a4 < 4; ++a4) {
            const f32x4 g4 = *(const f32x4*)(ng + 8 * a4);
            const u32x2 s0 = *(const u32x2*)(RA + e0 + 8 * a4), s1 = *(const u32x2*)(RA + e1 + 8 * a4);
            u32x2 w0, w1;
            w0.x = pk2(a0[4 * a4] * r0 * g4[0] * bflo(s0.x), a0[4 * a4 + 1] * r0 * g4[1] * bfhi(s0.x)); w0.y = pk2(a0[4 * a4 + 2] * r0 * g4[2] * bflo(s0.y), a0[4 * a4 + 3] * r0 * g4[3] * bfhi(s0.y));
            w1.x = pk2(a1[4 * a4] * r1 * g4[0] * bflo(s1.x), a1[4 * a4 + 1] * r1 * g4[1] * bfhi(s1.x)); w1.y = pk2(a1[4 * a4 + 2] * r1 * g4[2] * bflo(s1.y), a1[4 * a4 + 3] * r1 * g4[3] * bfhi(s1.y));
            *(u32x2*)(YG + e0 + 8 * a4) = w0; *(u32x2*)(YG + e1 + 8 * a4) = w1;
        }
    }
    __syncthreads();
}

__device__ __forceinline__ void ln1_router_phase(Frame& F, const Args& args) {
    const int tid = F.tid, lane = F.lane, wid = F.wave, tok = lane & 15, kg = lane >> 4;
    LAS float* LGT = (LAS float*)F.lds + wid * 1024;
    LAS unsigned* lcnt = (LAS unsigned*)(F.lds + 65536); LAS unsigned* lbase = lcnt + 32; LAS unsigned* rec = lcnt + 64;
    if (tid < 32) lcnt[tid] = 0u;
    if (tid < 64) rec[tid * 4 + 1] = 0xffffffffu;
    __syncthreads();
    float* X1 = F.out; const float* mods = (const float*)(F.ws + WS_MODS); bf16* U2 = (bf16*)(F.ws + WS_U2);
    const bf16* WH = (const bf16*)(F.ws + WS_WRT); const bf16* WL = WH + 48 * 1024;
    unsigned* cnt = (unsigned*)(F.ws + WS_CTL) + CW_CNT; unsigned* lst = (unsigned*)(F.ws + WS_LST); float* lstw = (float*)(F.ws + WS_LSTW);
    const int task = F.vcu * 4 + wid;
    if (wid < 4 && task < NTOK / 16) {
        const int m = task * 16 + tok, b = m >> 12;
        float* xr = X1 + (size_t)m * 1024 + kg * 8;
        float s = 0.f, q = 0.f;
#pragma unroll 8
        for (int j = 0; j < 32; ++j) { const f32x4 a = *(const f32x4*)(xr + 32 * j), c = *(const f32x4*)(xr + 32 * j + 4);
            s += (a[0] + a[1]) + (a[2] + a[3]) + (c[0] + c[1]) + (c[2] + c[3]);
            q += (a[0] * a[0] + a[1] * a[1]) + (a[2] * a[2] + a[3] * a[3]) + (c[0] * c[0] + c[1] * c[1]) + (c[2] * c[2] + c[3] * c[3]); }
        s += __shfl_xor(s, 16); s += __shfl_xor(s, 32); q += __shfl_xor(q, 16); q += __shfl_xor(q, 32);
        const float mean = s * (1.f / 1024.f), var = fmaxf(q * (1.f / 1024.f) - mean * mean, 0.f), rstd = rsqrtf(var + LN_EPS);
        f32x4 acc[3];
#pragma unroll
        for (int n = 0; n < 3; ++n) acc[n] = (f32x4){0.f, 0.f, 0.f, 0.f};
        const float* lg = args.in[12] + kg * 8; const float* lb = args.in[13] + kg * 8;
        const float* sc2 = mods + b * 6144 + 4 * 1024 + kg * 8; const float* sh2 = mods + b * 6144 + 3 * 1024 + kg * 8;
        const bf16* wh = WH + (size_t)tok * 1024 + kg * 8; const bf16* wl = WL + (size_t)tok * 1024 + kg * 8;
        bf16* u2r = U2 + (size_t)m * 1024 + kg * 8;
#pragma unroll 2
        for (int j = 0; j < 32; ++j) {
            const int o = 32 * j;
            const f32x4 xa = *(const f32x4*)(xr + o), xb = *(const f32x4*)(xr + o + 4);
            const f32x4 ga = *(const f32x4*)(lg + o), gb = *(const f32x4*)(lg + o + 4), ba = *(const f32x4*)(lb + o), bb = *(const f32x4*)(lb + o + 4);
            const f32x4 ca = *(const f32x4*)(sc2 + o), cb = *(const f32x4*)(sc2 + o + 4), ha = *(const f32x4*)(sh2 + o), hb = *(const f32x4*)(sh2 + o + 4);
            bf16x8 wfh[3], wfl[3];
#pragma unroll
            for (int n = 0; n < 3; ++n) { wfh[n] = *(const bf16x8*)(wh + (size_t)n * 16 * 1024 + o); wfl[n] = *(const bf16x8*)(wl + (size_t)n * 16 * 1024 + o); }
            const f32x4 x1a = (xa - mean) * rstd * ga + ba, x1b = (xb - mean) * rstd * gb + bb;
            *(f32x4*)(xr + o) = x1a; *(f32x4*)(xr + o + 4) = x1b;
            const f32x4 ua = x1a * (ca + 1.f) + ha, ub = x1b * (cb + 1.f) + hb;
            const u32x4 uh = pack8(ua, ub);
            *(u32x4*)(u2r + o) = uh;
            f32x4 ra, rb; unpack8(uh, ra, rb);
            const u32x4 ul = pack8(ua - ra, ub - rb);
            const bf16x8 fh = __builtin_bit_cast(bf16x8, uh), fl = __builtin_bit_cast(bf16x8, ul);
#pragma unroll
            for (int n = 0; n < 3; ++n) {
                acc[n] = __builtin_amdgcn_mfma_f32_16x16x32_bf16(wfh[n], fh, acc[n], 0, 0, 0);
                acc[n] = __builtin_amdgcn_mfma_f32_16x16x32_bf16(wfh[n], fl, acc[n], 0, 0, 0);
                acc[n] = __builtin_amdgcn_mfma_f32_16x16x32_bf16(wfl[n], fh, acc[n], 0, 0, 0);
            }
        }
#pragma unroll
        for (int n = 0; n < 3; ++n)
#pragma unroll
            for (int r = 0; r < 4; ++r) LGT[tok * 48 + 16 * n + 4 * kg + r] = acc[n][r];
        LDS_WAIT();
        if (lane < 16) {
            const LAS float* lt = LGT + lane * 48;
            float gl[4];
#pragma unroll
            for (int j = 0; j < 4; ++j) gl[j] = lt[j] + args.in[15][j];
            int gi = 0; float gm = gl[0];
#pragma unroll
            for (int j = 1; j < 4; ++j) if (gl[j] > gm) { gm = gl[j]; gi = j; }
            float gs = 0.f;
#pragma unroll
            for (int j = 0; j < 4; ++j) gs += __expf(gl[j] - gm);
            const float gval = 1.f / gs;
            float el[8];
#pragma unroll
            for (int j = 0; j < 8; ++j) el[j] = lt[4 + gi * 8 + j] + args.in[17][gi * 8 + j];
            int i1 = 0; float v1 = el[0];
#pragma unroll
            for (int j = 1; j < 8; ++j) if (el[j] > v1) { v1 = el[j]; i1 = j; }
            int i2 = (i1 == 0) ? 1 : 0; float v2 = (i1 == 0) ? el[1] : el[0];
#pragma unroll
            for (int j = 1; j < 8; ++j) if (j != i1 && el[j] > v2) { v2 = el[j]; i2 = j; }
            const float w1 = 1.f / (1.f + __expf(v2 - v1)), w2 = 1.f - w1;
            const int E1 = gi * 8 + i1, E2 = gi * 8 + i2, slot = wid * 16 + lane;
            const unsigned r1 = __hip_atomic_fetch_add(lcnt + E1, 1u, __ATOMIC_RELAXED, __HIP_MEMORY_SCOPE_WORKGROUP), r2 = __hip_atomic_fetch_add(lcnt + E2, 1u, __ATOMIC_RELAXED, __HIP_MEMORY_SCOPE_WORKGROUP);
            rec[slot * 4 + 0] = (unsigned)E1 | ((unsigned)E2 << 8) | (r1 << 16) | (r2 << 24); rec[slot * 4 + 1] = (unsigned)(task * 16 + lane);
            rec[slot * 4 + 2] = __float_as_uint(gval * w1); rec[slot * 4 + 3] = __float_as_uint(gval * w2);
        }
    }
    __syncthreads();
    if (tid < 32) { const unsigned n = lcnt[tid]; lbase[tid] = n ? atomicAdd(&cnt[tid * CNT_STRIDE], n) : 0u; }
    __syncthreads();
    if (tid < 64) {
        const unsigned r0 = rec[tid * 4], m = rec[tid * 4 + 1]; const unsigned E1 = r0 & 255u, E2 = (r0 >> 8) & 255u, p1 = lbase[E1] + ((r0 >> 16) & 255u), p2 = lbase[E2] + (r0 >> 24);
        if (m < (unsigned)NTOK) {
            lst[(size_t)E1 * NTOK + p1] = m * 2u; lstw[(size_t)E1 * NTOK + p1] = __uint_as_float(rec[tid * 4 + 2]);
            lst[(size_t)E2 * NTOK + p2] = m * 2u + 1u; lstw[(size_t)E2 * NTOK + p2] = __uint_as_float(rec[tid * 4 + 3]);
        }
    }
    __syncthreads();
}
__device__ __forceinline__ void moe_tiles(Frame& F) {
    LAS int* ts = (LAS int*)(F.lds + LDS_TS);
    __syncthreads();
    if (F.tid == 0) { const unsigned* cnt = (const unsigned*)(F.ws + WS_CTL) + CW_CNT; int a = 0; for (int e = 0; e < 32; ++e) { ts[e] = a; a += (int)((__hip_atomic_load(cnt + e * CNT_STRIDE, __ATOMIC_RELAXED, __HIP_MEMORY_SCOPE_AGENT) + 255u) >> 8); } ts[32] = a; }
    __syncthreads();
}
__device__ __forceinline__ void final_phase(Frame& F, const Args& args) {
    const int gw = F.vcu * NWAVES + F.wave, NGW = F.G * NWAVES, lane = F.lane;
    const float* mods = (const float*)(F.ws + WS_MODS); const bf16* Y = (const bf16*)(F.ws + WS_Y);
#pragma unroll 1
    for (int m = gw; m < NTOK; m += NGW) {
        const int b = m >> 12; f32x4* xr = (f32x4*)(F.out + (size_t)m * 1024) + lane;
        const f32x4* g2 = (const f32x4*)(mods + b * 6144 + 5 * 1024) + lane;
        const u32x2* y0 = (const u32x2*)(Y + (size_t)m * 1024) + lane; const u32x2* y1 = (const u32x2*)(Y + ((size_t)NTOK + m) * 1024) + lane;
        f32x4 v[4]; float s = 0.f;
#pragma unroll
        for (int j = 0; j < 4; ++j) { const u32x2 a = y0[64 * j], c = y1[64 * j];
            const f32x4 y = (f32x4){bflo(a.x) + bflo(c.x), bfhi(a.x) + bfhi(c.x), bflo(a.y) + bflo(c.y), bfhi(a.y) + bfhi(c.y)};
            v[j] = xr[64 * j] * ALPHA + g2[64 * j] * y; s += (v[j][0] + v[j][1]) + (v[j][2] + v[j][3]); }
        const float mean = wave_sum(s) * (1.f / 1024.f); float s2 = 0.f;
#pragma unroll
        for (int j = 0; j < 4; ++j) { v[j] = v[j] - mean; s2 += (v[j][0] * v[j][0] + v[j][1] * v[j][1]) + (v[j][2] * v[j][2] + v[j][3] * v[j][3]); }
        const float rstd = rsqrtf(wave_sum(s2) * (1.f / 1024.f) + LN_EPS);
        const f32x4* lg = (const f32x4*)args.in[21] + lane; const f32x4* lb = (const f32x4*)args.in[22] + lane;
#pragma unroll
        for (int j = 0; j < 4; ++j) xr[64 * j] = v[j] * rstd * lg[64 * j] + lb[64 * j];
    }
}

#if NAIVE_ATTN
__device__ __forceinline__ void attn_naive(Frame& F) {
    const int gw = F.vcu * NWAVES + F.wave, NGW = F.G * NWAVES, lane = F.lane;
    LAS float* pl = (LAS float*)(F.lds) + F.wave * 256;
    bf16* QD = (bf16*)(F.ws + WS_QD); const bf16* KD = (const bf16*)(F.ws + WS_KD); const bf16* VD = (const bf16*)(F.ws + WS_VD);
    float* LSE = (float*)(F.ws + WS_LSE); const float* BT = (const float*)(F.ws + WS_BTAB);
#pragma unroll 1
    for (int w = gw; w < NTOK * 24; w += NGW) {
        const int m = w / 24, gh = w % 24, g = gh >> 3, dil = 1 << (2 * g), b = m >> 12, s = m & 4095;
        const bf16* q = QD + (size_t)m * 1536 + gh * 64;
        float sc[3]; float mx = -INFINITY;
#pragma unroll
        for (int p = 0; p < 3; ++p) {
            const int mm = lane + 64 * p; const int sk = s - mm * dil; float v = -INFINITY;
            if (mm <= 128 && sk >= 0) { const bf16* k = KD + (size_t)(b * SEQ + sk) * 1536 + gh * 64; float d = 0.f; for (int e = 0; e < 64; ++e) d += bf2f(q[e]) * bf2f(k[e]); v = d + BT[gh * 132 + mm]; }
            sc[p] = v; mx = fmaxf(mx, v);
        }
#pragma unroll
        for (int o = 1; o < 64; o <<= 1) mx = fmaxf(mx, __shfl_xor(mx, o));
        float sum = 0.f;
#pragma unroll
        for (int p = 0; p < 3; ++p) { const float e = __expf(sc[p] - mx); if (lane + 64 * p < 256) pl[lane + 64 * p] = e; sum += e; }
        sum = wave_sum(sum);
        LDS_WAIT();
        float o = 0.f;
        for (int mm = 0; mm <= 128; ++mm) { const int sk = s - mm * dil; if (sk >= 0) o += pl[mm] * bf2f(VD[(size_t)(b * SEQ + sk) * 1536 + gh * 64 + lane]); }
        LDS_WAIT();
        QD[(size_t)m * 1536 + gh * 64 + lane] = f2bf(o / sum);
        if (lane == 0) LSE[(size_t)m * 24 + gh] = mx + __logf(sum);
    }
    __syncthreads();
}
#endif
#if NAIVE_GLA || DBG_GLA_DIFF
__device__ __forceinline__ void gla_naive(Frame& F, const Args& args) {
    const int tid = F.tid;
    LAS float* A = (LAS float*)F.lds;
    LAS float* Qs = A + 8192; LAS float* Ks = Qs + 8192; LAS float* Vs = Ks + 8192;
    LAS float* Os = Vs + 1024;
    const bf16* QA = (const bf16*)(F.ws + WS_QA); const bf16* KA = (const bf16*)(F.ws + WS_KA); const bf16* VA = (const bf16*)(F.ws + WS_VA);
    const float* LR = (const float*)(F.ws + WS_LR); float* OF = (float*)(F.ws + WS_DS);
    const int U = F.vcu; if (U < 256) {
    const int bh = U >> 4, vt = U & 15, b = bh >> 2, h = bh & 3;
    float st[8];
#pragma unroll
    for (int j = 0; j < 8; ++j) st[j] = 0.f;
    const int v = tid & 15, kg = (tid >> 4) & 15;
    for (int c = 0; c < 64; ++c) {
        const size_t tok0 = (size_t)b * SEQ + c * 64;
        __syncthreads();
        for (int i = tid; i < 8192; i += NTHR) { const int t = i >> 7, k = i & 127; float lg = args.in[7][h * 128 + k];
            for (int j = 0; j < 16; ++j) lg += LR[(tok0 + t) * 16 + j] * args.in[6][j * 512 + h * 128 + k];
            A[i] = __expf(log_sigmoid_(lg) * (1.f / 16.f)); Qs[i] = bf2f(QA[(tok0 + t) * 512 + h * 128 + k]); Ks[i] = bf2f(KA[(tok0 + t) * 512 + h * 128 + k]); }
        for (int i = tid; i < 1024; i += NTHR) { Vs[i] = bf2f(VA[(tok0 + (i >> 4)) * 1024 + h * 256 + vt * 16 + (i & 15)]); Os[i] = 0.f; }
        __syncthreads();
        if (tid < 256) {
            for (int t = 0; t < 64; ++t) { const float vv = Vs[t * 16 + v]; float o = 0.f;
#pragma unroll
                for (int j = 0; j < 8; ++j) { const int k = kg * 8 + j; st[j] = st[j] * A[t * 128 + k] + Ks[t * 128 + k] * vv; o += Qs[t * 128 + k] * st[j]; }
                o += __shfl_xor(o, 16); o += __shfl_xor(o, 32);
                if ((kg & 3) == 0) Os[(tid >> 6) * 1024 + t * 16 + v] = o;
            }
        }
        __syncthreads();
        for (int i = tid; i < 1024; i += NTHR) OF[(tok0 + (i >> 4)) * 1024 + h * 256 + vt * 16 + (i & 15)] = (Os[i] + Os[1024 + i]) + (Os[2048 + i] + Os[3072 + i]);
    }
    }
    __syncthreads();
}
__device__ __forceinline__ void gla_naive_norm(Frame& F, const Args& args, size_t ws_out = WS_YGLA) {
    const int gw = F.vcu * NWAVES + F.wave, NGW = F.G * NWAVES, lane = F.lane;
    const float* OF = (const float*)(F.ws + WS_DS); const bf16* RA = (const bf16*)(F.ws + WS_RA); bf16* YG = (bf16*)(F.ws + ws_out);
#pragma unroll 1
    for (int w = gw; w < NTOK * 4; w += NGW) {
        const size_t e = (size_t)(w >> 2) * 1024 + (w & 3) * 256 + lane * 4; const f32x4 o = *(const f32x4*)(OF + e);
        const float ss = wave_sum(o[0] * o[0] + o[1] * o[1] + o[2] * o[2] + o[3] * o[3]); const float rs = rsqrtf(ss * (1.f / 256.f) + LN_EPS);
        const float* ng = args.in[8] + (w & 3) * 256 + lane * 4;
#pragma unroll
        for (int j = 0; j < 4; ++j) YG[e + j] = f2bf(o[j] * rs * ng[j] * bf2f(RA[e + j]));
    }
}
#endif

enum { PH_P0 = 0, PH_P0B, PH_INPROJ, PH_ATTN, PH_GLAA, PH_SCAN, PH_GLAC, PH_PROJ, PH_OUT, PH_LN1, PH_MOE1, PH_MOE2, PH_FINAL, NPH };

__global__ void __launch_bounds__(NTHR, 2) mega_fwd(Args args) {
    extern __shared__ __attribute__((aligned(16))) unsigned char lds_raw[];
    Frame F;
    F.lds = (LAS unsigned char*)lds_raw;
    F.tid = threadIdx.x; F.lane = F.tid & 63; F.wave = __builtin_amdgcn_readfirstlane(F.tid >> 6);
    F.G = gridDim.x; { const int bx = blockIdx.x; F.vcu = (F.G % 8 == 0) ? (bx % 8) * (F.G / 8) + bx / 8 : bx; }
    F.ws = args.ws; F.out = args.out;
    for (int u = F.tid; u < (LDS_BYTES - LDSCTL_OFF) / 4; u += NTHR) ((LAS unsigned*)(F.lds + LDSCTL_OFF))[u] = 0u;
    __syncthreads();
    const int lo = args.ph_lo, hi = args.ph_hi;
    XcdBarrier bar; bar.bar = (unsigned*)(F.ws + WS_CTL) + CW_BAR; bar.x = 0; bar.st = nullptr;
    if (hi - lo > 1) bar = xcd_barrier_post((unsigned*)(F.ws + WS_CTL) + CW_BAR, (volatile LAS unsigned*)(F.lds + LDSCTL_OFF));
#ifndef PHASE_MASK
#define PHASE_MASK 0xFFFF
#endif
#define IN(k) (((PHASE_MASK >> (k)) & 1) && lo <= (k) && (k) < hi)
#define SEAM(k) do { if (IN(k) && IN((k) + 1)) xcd_barrier(bar); } while (0)
    unsigned char* ws = F.ws;
    bf16* GA = (bf16*)F.out; bf16* GD = GA + (size_t)NTOK * 1024;

    if (IN(PH_P0)) { frame_refresh(F); p0_phase(F, args); } SEAM(PH_P0);
    if (IN(PH_P0B)) { frame_refresh(F); p0b_phase(F, args); } SEAM(PH_P0B);
    if (IN(PH_INPROJ)) { frame_refresh(F);
        pg8::DenseOrder S; S.init(NTOK, INPAD, 1024, F.G, (int)blockIdx.x);
        run_gemm(F, (const bf16*)(ws + WS_U), (const bf16*)(ws + WS_WIN), 1024, S, EpiInProj{ws, GA, GD});
    } SEAM(PH_INPROJ);
    if (IN(PH_ATTN)) { frame_refresh(F);
#if NAIVE_ATTN
        attn_naive(F);
#else
        attn_phase(F);
#endif
    } SEAM(PH_ATTN);
    if (IN(PH_GLAA)) { frame_refresh(F);
#if NAIVE_GLA
        gla_naive(F, args);
#else
        gla_a_phase(F, args);
#endif
        combine_phase(F);
    } SEAM(PH_GLAA);
    if (IN(PH_SCAN)) { frame_refresh(F);
#if !NAIVE_GLA
        gla_scan_phase(F);
#endif
    } SEAM(PH_SCAN);
    if (IN(PH_GLAC)) { frame_refresh(F);
#if NAIVE_GLA
        gla_naive_norm(F, args);
#else
        gla_c_phase(F, args);
#endif
    } SEAM(PH_GLAC);
    if (IN(PH_PROJ)) { frame_refresh(F);
        const bool conv_first = (blockIdx.x & 8) != 0;
        if (conv_first) { convert_experts(F, args); __syncthreads(); }
        pg8::DenseOrder S; S.init(NTOK, 1024, 512, F.G, (int)blockIdx.x);
        run_gemm(F, (const bf16*)(ws + WS_YATT), (const bf16*)(ws + WS_WPA), 512, S, EpiProjA{GD, (bf16*)(ws + WS_TT)});
        VM_WAIT(); __syncthreads();
        pg8::DenseOrder S2; S2.init(NTOK, 1024, 1024, F.G, (int)blockIdx.x);
        run_gemm(F, (const bf16*)(ws + WS_YGLA), (const bf16*)(ws + WS_WPG), 1024, S2, EpiProjG{GA, (const bf16*)(ws + WS_TT), (bf16*)(ws + WS_MERGED)});
        if (!conv_first) convert_experts(F, args);
    } SEAM(PH_PROJ);
    if (IN(PH_OUT)) { frame_refresh(F);
        pg8::DenseOrder S; S.init(NTOK, 1024, 1024, F.G, (int)blockIdx.x);
        run_gemm(F, (const bf16*)(ws + WS_MERGED), (const bf16*)(ws + WS_WOUT), 1024, S, EpiOut{args.in[0], (const float*)(ws + WS_MODS), F.out});
    } SEAM(PH_OUT);
    if (IN(PH_LN1)) { frame_refresh(F); ln1_router_phase(F, args); } SEAM(PH_LN1);
    if (IN(PH_MOE1)) { frame_refresh(F);
        moe_tiles(F);
        MoeOrder S{(const LAS int*)(F.lds + LDS_TS), (const unsigned*)(ws + WS_CTL) + CW_CNT, (const unsigned*)(ws + WS_LST), F.G, F.vcu, 0};
        run_gemm(F, (const bf16*)(ws + WS_U2), (const bf16*)(ws + WS_WGU), 1024, S, EpiMoeUp{(bf16*)(ws + WS_H)});
    } SEAM(PH_MOE1);
    if (IN(PH_MOE2)) { frame_refresh(F);
        moe_tiles(F);
        MoeOrder S{(const LAS int*)(F.lds + LDS_TS), (const unsigned*)(ws + WS_CTL) + CW_CNT, (const unsigned*)(ws + WS_LST), F.G, F.vcu, 1};
        run_gemm(F, (const bf16*)(ws + WS_H), (const bf16*)(ws + WS_WDN), 512, S, EpiMoeDown{(const unsigned*)(ws + WS_CTL) + CW_CNT, (const unsigned*)(ws + WS_LST), (const float*)(ws + WS_LSTW), (bf16*)(ws + WS_Y)});
    } SEAM(PH_MOE2);
    if (IN(PH_FINAL)) { frame_refresh(F); final_phase(F, args); }
#if DBG_GLA_DIFF
    if (lo == 13) { frame_refresh(F); gla_naive(F, args); }
    if (lo == 14) { frame_refresh(F); gla_naive_norm(F, args, WS_TT); }
    if (lo == 15) { frame_refresh(F);
        const bf16* ya = (const bf16*)(ws + DBG_SRC);
        for (size_t i = (size_t)blockIdx.x * NTHR + F.tid; i < (size_t)NTOK * 1024; i += (size_t)F.G * NTHR) { float d = bf2f(ya[i]); if (!(fabsf(d) < 1e30f)) d = 1e4f; F.out[i] = d; } }
#endif
#undef IN
#undef SEAM
}

extern "C" void kernel_launch(void* const* d_in, const int* in_sizes, int n_in, void* d_out, int out_size, void* d_ws, size_t ws_size, hipStream_t stream) {
    static int grid = 0;
    if (grid == 0) {
        if (n_in != 23 || out_size != NTOK * D || ws_size < WS_END) { fprintf(stderr, "kernel_launch: unexpected shapes (n_in %d out %d ws %zu, need %zu)\n", n_in, out_size, ws_size, (size_t)WS_END); grid = -1; return; }
        int dev = 0, cus = 0;
        if (hipGetDevice(&dev) != hipSuccess || hipDeviceGetAttribute(&cus, hipDeviceAttributeMultiprocessorCount, dev) != hipSuccess) { grid = -1; return; }
        if (hipFuncSetAttribute((const void*)mega_fwd, hipFuncAttributeMaxDynamicSharedMemorySize, LDS_BYTES) != hipSuccess) { fprintf(stderr, "kernel_launch: hipFuncSetAttribute failed\n"); grid = -1; return; }
        int per_cu = 0;
        if (hipOccupancyMaxActiveBlocksPerMultiprocessor(&per_cu, (const void*)mega_fwd, NTHR, LDS_BYTES) != hipSuccess || per_cu < 1) fprintf(stderr, "kernel_launch: occupancy query reports %d\n", per_cu);
        (void)hipGetLastError();
        grid = cus - (cus % 8);
        if (grid > 256) grid = 256;
        if (grid != 256) { fprintf(stderr, "kernel_launch: needs 256 CUs, found %d\n", cus); grid = -1; return; }
    }
    if (grid < 0) return;
    (void)hipMemsetAsync((char*)d_ws + WS_CTL, 0, CTL_ZERO_BYTES, stream);
    Args a{};
    for (int i = 0; i < 23; ++i) a.in[i] = (const float*)d_in[i];
    a.out = (float*)d_out; a.ws = (unsigned char*)d_ws;
#if DBG_GLA_DIFF
    { const int seq[] = DBG_SEQ;
      for (int k = 0; k < (int)(sizeof(seq) / sizeof(int)); ++k) { a.ph_lo = seq[k]; a.ph_hi = seq[k] + 1; hipLaunchKernelGGL(mega_fwd, dim3(grid), dim3(NTHR), LDS_BYTES, stream, a); } }
#elif MK_MULTI
    { const int seq[] = MULTI_SEQ;
      for (int k = 0; k < (int)(sizeof(seq) / sizeof(int)); ++k) { a.ph_lo = seq[k]; a.ph_hi = seq[k] + 1; hipLaunchKernelGGL(mega_fwd, dim3(grid), dim3(NTHR), LDS_BYTES, stream, a); } }
#else
    a.ph_lo = 0; a.ph_hi = NPH;
    hipLaunchKernelGGL(mega_fwd, dim3(grid), dim3(NTHR), LDS_BYTES, stream, a);
#endif
}
```
